# Optimizing an MI355X kernel written in HIP

```python
import math
import jax, jax.numpy as jnp
from jax import lax
import numpy as np

D_MODEL = 1024
BATCH = 8
SEQ = 4096
DEPTH = 2

HEAD_DIM = 64
N_MEM = 256
MEM_HEADS = 4
MEM_WIDTH = MEM_HEADS * HEAD_DIM
RWKV_HEADS = 12
RWKV_WIDTH = RWKV_HEADS * HEAD_DIM
DECAY_LORA = 64
AAA_LORA = 64
GATE_LORA = 128
SHIFT_WIDTH = 3 * RWKV_WIDTH + DECAY_LORA + AAA_LORA + GATE_LORA
A_IN_WIDTH = SHIFT_WIDTH + MEM_WIDTH
A_OUT_WIDTH = RWKV_WIDTH + MEM_WIDTH
DIL_GROUPS = ((128, 1), (512, 4), (2048, 16))
DIL_HEADS_PER_GROUP = 4
DIL_HEADS = DIL_HEADS_PER_GROUP * len(DIL_GROUPS)
DIL_WIDTH = DIL_HEADS * HEAD_DIM
DIL_BLOCK = 128
B_IN_WIDTH = DIL_WIDTH + MEM_WIDTH
B_OUT_WIDTH = DIL_HEADS_PER_GROUP * HEAD_DIM + MEM_WIDTH
D_FF = 2816
CONV_WIDTH = 3
ROPE_THETA = 10000.0
RMS_EPS = 1e-6
LNX_EPS = 64e-5
NEG_INF = -1e30
N_A = DEPTH // 2
N_B = DEPTH - N_A

kernel_name = "yoco_rwkv7_dilated_memory_convffn"


def f32(a):
    return a.astype(jnp.float32)


def rmsnorm(x, g):
    xf = f32(x)
    return xf * lax.rsqrt(jnp.mean(xf * xf, axis=-1, keepdims=True) + RMS_EPS) * f32(g)


def rope_tables(T):
    inv = ROPE_THETA ** (-jnp.arange(0, HEAD_DIM, 2, dtype=jnp.float32) / HEAD_DIM)
    ang = jnp.arange(T, dtype=jnp.float32)[:, None] * inv[None, :]
    return jnp.cos(ang)[:, None, :], jnp.sin(ang)[:, None, :]


def apply_rope(z, cos, sin):
    half = HEAD_DIM // 2
    z1, z2 = z[..., :half], z[..., half:]
    return jnp.concatenate([z1 * cos - z2 * sin, z2 * cos + z1 * sin], axis=-1)


def rwkv7_time_mix(p, mu, w0, w2, a0, a2, g2, k_k, k_a, r_k, lnx_w, lnx_b):
    B, T, _ = p.shape
    prev = jnp.pad(p[:, :-1], ((0, 0), (1, 0), (0, 0)))
    xs = p + (prev - p) * f32(mu)
    cuts = np.cumsum([RWKV_WIDTH, RWKV_WIDTH, RWKV_WIDTH, DECAY_LORA, AAA_LORA]).tolist()
    r, k, v, wd, ad, gd = jnp.split(xs, cuts, axis=-1)
    w_log = -jax.nn.softplus(-(f32(w0) + jnp.tanh(wd) @ f32(w2))) - 0.5
    decay = jnp.exp(-jnp.exp(w_log))
    a = jax.nn.sigmoid(f32(a0) + ad @ f32(a2))
    g = jax.nn.sigmoid(gd) @ f32(g2)
    heads = lambda z: z.reshape(B, T, RWKV_HEADS, HEAD_DIM)
    kk = heads(k * f32(k_k))
    kk = kk / jnp.maximum(jnp.linalg.norm(kk, axis=-1, keepdims=True), 1e-12)
    k = k * (1.0 + (a - 1.0) * f32(k_a))
    r_h, k_h, v_h, w_h, a_h = heads(r), heads(k), heads(v), heads(decay), heads(a)

    def step(S, inp):
        r_t, w_t, k_t, v_t, kk_t, a_t = inp
        sa = jnp.einsum('bhvk,bhk->bhv', S, -kk_t)
        S = (S * w_t[:, :, None, :] + sa[..., None] * (kk_t * a_t)[:, :, None, :]
             + v_t[..., None] * k_t[:, :, None, :])
        return S, jnp.einsum('bhvk,bhk->bhv', S, r_t)

    seq = tuple(jnp.moveaxis(z, 1, 0) for z in (r_h, w_h, k_h, v_h, kk, a_h))
    S0 = jnp.zeros((B, RWKV_HEADS, HEAD_DIM, HEAD_DIM), jnp.float32)
    _, ys = lax.scan(step, S0, seq)
    y = jnp.moveaxis(ys, 0, 1)
    m = jnp.mean(y, axis=-1, keepdims=True)
    var = jnp.mean((y - m) ** 2, axis=-1, keepdims=True)
    y = ((y - m) * lax.rsqrt(var + LNX_EPS)).reshape(B, T, RWKV_WIDTH) * f32(lnx_w) + f32(lnx_b)
    bonus = (jnp.sum(r_h * k_h * f32(r_k), axis=-1, keepdims=True) * v_h).reshape(B, T, RWKV_WIDTH)
    return (y + bonus) * g


def dilated_group_attention(q, k, v, window, dilation):
    B, T, H, Dh = q.shape
    back = window // dilation
    span = dilation * DIL_BLOCK
    Tp = ((T + span - 1) // span) * span
    U = Tp // dilation
    nb = U // DIL_BLOCK

    def to_blocks(z):
        z = jnp.pad(z, ((0, 0), (0, Tp - T), (0, 0), (0, 0)))
        z = z.reshape(B, U, dilation, H, Dh).transpose(0, 3, 2, 1, 4)
        return z.reshape(B, H, dilation, nb, DIL_BLOCK, Dh)

    def with_prev(z):
        prev = jnp.pad(z, ((0, 0), (0, 0), (0, 0), (1, 0), (0, 0), (0, 0)))[:, :, :, :-1]
        return jnp.concatenate([prev, z], axis=4)

    qb = to_blocks(q)
    kw, vw = with_prev(to_blocks(k)), with_prev(to_blocks(v))
    s = jnp.einsum('bhrnid,bhrnjd->bhrnij', qb, kw) / math.sqrt(Dh)
    i = jnp.arange(DIL_BLOCK)[:, None]
    jj = jnp.arange(2 * DIL_BLOCK)[None, :]
    dist = DIL_BLOCK + i - jj
    band = (dist >= 0) & (dist <= back)
    valid = band[None] & ((jnp.arange(nb) > 0)[:, None, None] | (jj >= DIL_BLOCK)[None])
    s = jnp.where(valid, s, NEG_INF)
    mx = jnp.max(s, axis=-1, keepdims=True)
    pr = jnp.exp(s - mx)
    den = jnp.sum(pr, axis=-1, keepdims=True)
    o = jnp.einsum('bhrnij,bhrnjd->bhrnid', pr, vw) / den
    lse = (mx + jnp.log(den))[..., 0]
    o = o.reshape(B, H, dilation, U, Dh).transpose(0, 3, 2, 1, 4).reshape(B, Tp, H, Dh)[:, :T]
    lse = lse.reshape(B, H, dilation, U).transpose(0, 3, 2, 1).reshape(B, Tp, H)[:, :T]
    return o, lse


def dilated_attention(q, k, v):
    B, T = q.shape[:2]
    outs, lses = [], []
    for gi, (win, dil) in enumerate(DIL_GROUPS):
        hs = slice(gi * DIL_HEADS_PER_GROUP, (gi + 1) * DIL_HEADS_PER_GROUP)
        o, l = dilated_group_attention(q[:, :, hs], k[:, :, hs], v[:, :, hs], win, dil)
        outs.append(o)
        lses.append(l)
    wgt = jax.nn.softmax(jnp.stack(lses, axis=0), axis=0)
    o = jnp.sum(wgt[..., None] * jnp.stack(outs, axis=0), axis=0)
    return o.reshape(B, T, DIL_HEADS_PER_GROUP * HEAD_DIM)


def memory_attention(q, mem, norm_g, w_kv, q_norm, k_norm):
    B, T, _ = q.shape
    M = mem.shape[1]
    kv = f32(rmsnorm(mem, norm_g).astype(mem.dtype) @ w_kv)
    k = rmsnorm(kv[..., :MEM_WIDTH].reshape(B, M, MEM_HEADS, HEAD_DIM), k_norm)
    v = kv[..., MEM_WIDTH:].reshape(B, M, MEM_HEADS, HEAD_DIM)
    qh = rmsnorm(q.reshape(B, T, MEM_HEADS, HEAD_DIM), q_norm)
    s = jnp.einsum('bthd,bmhd->bhtm', qh, k) / math.sqrt(HEAD_DIM)
    p = jax.nn.softmax(s, axis=-1)
    return jnp.einsum('bhtm,bmhd->bthd', p, v).reshape(B, T, MEM_WIDTH)


def conv_ffn(x, g, w_up, conv_w, conv_b, w_down):
    T = x.shape[1]
    u = f32(rmsnorm(x, g).astype(x.dtype) @ w_up)
    up = jnp.pad(u, ((0, 0), (CONV_WIDTH - 1, 0), (0, 0)))
    c = f32(conv_b) + sum(f32(conv_w[j]) * up[:, j:j + T] for j in range(CONV_WIDTH))
    gate, val = jnp.split(c, 2, axis=-1)
    z = jax.nn.silu(gate) * val
    return z.astype(x.dtype) @ w_down


def setup_inputs(seed: int = 0) -> dict:
    key = jax.random.key(seed)
    ks = iter(jax.random.split(key, 40))
    D = D_MODEL

    def nrm(shape, scale):
        return scale * jax.random.normal(next(ks), shape, jnp.float32)

    def unif(shape, lo, hi):
        return jax.random.uniform(next(ks), shape, jnp.float32, lo, hi)

    def gain(shape):
        return 1.0 + nrm(shape, 0.02)

    return {
        "x": nrm((BATCH, SEQ, D), 1.0),
        "mem": nrm((BATCH, N_MEM, D), 1.0),
        "attn_norm": gain((DEPTH, D)),
        "a_w_in": nrm((N_A, D, A_IN_WIDTH), D ** -0.5),
        "a_mu": unif((N_A, SHIFT_WIDTH), 0.0, 1.0),
        "a_w0": unif((N_A, RWKV_WIDTH), -5.0, 0.0),
        "a_w2": nrm((N_A, DECAY_LORA, RWKV_WIDTH), 0.5 * DECAY_LORA ** -0.5),
        "a_a0": nrm((N_A, RWKV_WIDTH), 0.5),
        "a_a2": nrm((N_A, AAA_LORA, RWKV_WIDTH), AAA_LORA ** -0.5),
        "a_g2": nrm((N_A, GATE_LORA, RWKV_WIDTH), GATE_LORA ** -0.5),
        "a_k_k": 0.85 + nrm((N_A, RWKV_WIDTH), 0.05),
        "a_k_a": 1.0 + nrm((N_A, RWKV_WIDTH), 0.05),
        "a_r_k": nrm((N_A, RWKV_HEADS, HEAD_DIM), 0.1),
        "a_lnx_w": gain((N_A, RWKV_WIDTH)),
        "a_lnx_b": nrm((N_A, RWKV_WIDTH), 0.02),
        "a_w_out": nrm((N_A, A_OUT_WIDTH, D), A_OUT_WIDTH ** -0.5),
        "kv_norm": gain((D,)),
        "kv_w": nrm((D, 2 * DIL_WIDTH), D ** -0.5),
        "kv_k_norm": gain((HEAD_DIM,)),
        "b_w_in": nrm((N_B, D, B_IN_WIDTH), D ** -0.5),
        "b_q_norm": gain((N_B, HEAD_DIM)),
        "b_w_out": nrm((N_B, B_OUT_WIDTH, D), B_OUT_WIDTH ** -0.5),
        "mem_norm": gain((DEPTH, D)),
        "mem_w_kv": nrm((DEPTH, D, 2 * MEM_WIDTH), D ** -0.5),
        "mem_q_norm": gain((DEPTH, HEAD_DIM)),
        "mem_k_norm": gain((DEPTH, HEAD_DIM)),
        "ffn_norm": gain((DEPTH, D)),
        "ffn_w_up": nrm((DEPTH, D, 2 * D_FF), D ** -0.5),
        "ffn_conv_w": nrm((DEPTH, CONV_WIDTH, 2 * D_FF), CONV_WIDTH ** -0.5),
        "ffn_conv_b": nrm((DEPTH, 2 * D_FF), 0.02),
        "ffn_w_down": nrm((DEPTH, D_FF, D), D_FF ** -0.5),
    }


def reference(x, mem, attn_norm, a_w_in, a_mu, a_w0, a_w2, a_a0, a_a2, a_g2, a_k_k, a_k_a,
              a_r_k, a_lnx_w, a_lnx_b, a_w_out, kv_norm, kv_w, kv_k_norm, b_w_in, b_q_norm,
              b_w_out, mem_norm, mem_w_kv, mem_q_norm, mem_k_norm, ffn_norm, ffn_w_up,
              ffn_conv_w, ffn_conv_b, ffn_w_down):
    B, T, _ = x.shape
    cos, sin = rope_tables(T)
    k_sh = v_sh = None
    for i in range(DEPTH):
        h = rmsnorm(x, attn_norm[i]).astype(x.dtype)
        if i < N_A:
            j = i
            p = f32(h @ a_w_in[j])
            y_mix = rwkv7_time_mix(p[..., :SHIFT_WIDTH], a_mu[j], a_w0[j], a_w2[j], a_a0[j],
                                   a_a2[j], a_g2[j], a_k_k[j], a_k_a[j], a_r_k[j],
                                   a_lnx_w[j], a_lnx_b[j])
            q_mem = p[..., SHIFT_WIDTH:]
            w_out = a_w_out[j]
        else:
            j = i - N_A
            if j == 0:
                kvp = f32(rmsnorm(x, kv_norm).astype(x.dtype) @ kv_w)
                k_sh = apply_rope(rmsnorm(kvp[..., :DIL_WIDTH].reshape(B, T, DIL_HEADS, HEAD_DIM),
                                          kv_k_norm), cos, sin)
                v_sh = kvp[..., DIL_WIDTH:].reshape(B, T, DIL_HEADS, HEAD_DIM)
            p = f32(h @ b_w_in[j])
            q = apply_rope(rmsnorm(p[..., :DIL_WIDTH].reshape(B, T, DIL_HEADS, HEAD_DIM),
                                   b_q_norm[j]), cos, sin)
            y_mix = dilated_attention(q, k_sh, v_sh)
            q_mem = p[..., DIL_WIDTH:]
            w_out = b_w_out[j]
        y_mem = memory_attention(q_mem, mem, mem_norm[i], mem_w_kv[i], mem_q_norm[i], mem_k_norm[i])
        y = jnp.concatenate([y_mix, y_mem], axis=-1).astype(x.dtype)
        x = x + y @ w_out
        x = x + conv_ffn(x, ffn_norm[i], ffn_w_up[i], ffn_conv_w[i], ffn_conv_b[i], ffn_w_down[i])
    return x
```

```cpp
#include <hip/hip_runtime.h>
#include <hip/hip_cooperative_groups.h>
#include <cstdio>
#include <cstdint>
namespace cg = cooperative_groups;

#define LAS __attribute__((address_space(3)))
typedef unsigned short bf16_t;
typedef short bf16x8 __attribute__((ext_vector_type(8)));
typedef short s16x4 __attribute__((ext_vector_type(4)));
typedef float f32x4 __attribute__((ext_vector_type(4)));
typedef float f32x2 __attribute__((ext_vector_type(2)));
typedef unsigned u32x4 __attribute__((ext_vector_type(4)));
typedef unsigned u32x2 __attribute__((ext_vector_type(2)));
typedef __bf16 bf16x2_t __attribute__((ext_vector_type(2)));

constexpr int NB = 8, T = 4096, D = 1024, M = NB * T;
constexpr int AIN = 2816, SHIFTW = 2560, RW = 768, FF = 2816, FF2 = 5632, IN1 = 2560, NMEM = 256;
constexpr float RMS_EPS = 1e-6f, LNX_EPS = 64e-5f;

constexpr size_t MiB = 1u << 20;
constexpr size_t WS_CTL = 0;
constexpr size_t WS_WAIN = 1 * MiB;
constexpr size_t WS_WAOUT = WS_WAIN + (size_t)AIN * D * 2;
constexpr size_t WS_WIN1 = WS_WAOUT + (size_t)D * D * 2;
constexpr size_t WS_WBOUT = WS_WIN1 + (size_t)IN1 * D * 2;
constexpr size_t WS_WMEM = WS_WBOUT + (size_t)D * 512 * 2;
constexpr size_t WS_WUP0 = WS_WMEM + (size_t)D * D * 2;
constexpr size_t WS_WUP1 = WS_WUP0 + (size_t)FF2 * D * 2;
constexpr size_t WS_WDN0 = WS_WUP1 + (size_t)FF2 * D * 2;
constexpr size_t WS_WDN1 = WS_WDN0 + (size_t)D * FF * 2;
constexpr size_t WS_WLORA = WS_WDN1 + (size_t)D * FF * 2;
constexpr size_t WS_ROPE = WS_WLORA + (size_t)2304 * 256 * 2;
constexpr size_t WS_MEMN = WS_ROPE + (size_t)T * 32 * 4 * 2;
constexpr size_t WS_MEMKV = WS_MEMN + (size_t)2048 * D * 2;
constexpr size_t WS_LSE = WS_MEMKV + (size_t)2048 * D * 2;
constexpr size_t WS_SSQ = WS_LSE + (size_t)3 * M * 4 * 4;
constexpr size_t WS_RS = WS_SSQ + (size_t)M * 16 * 4;
constexpr size_t WS_WEND = WS_RS + (size_t)M * 4;
static_assert(WS_WEND <= 64 * MiB, "weight region");
constexpr size_t WS_A = 64 * MiB;
constexpr size_t WS_Y = 128 * MiB;
constexpr size_t WS_X2 = 64 * MiB;
constexpr size_t WS_P = 192 * MiB;
constexpr size_t WS_S = 368 * MiB;
constexpr size_t WS_WL = WS_S, WS_KMOD = WS_S + 48 * MiB, WS_G = WS_S + 96 * MiB;
constexpr size_t WS_HU0 = WS_S;
constexpr size_t WS_XN1 = WS_S, WS_Y1 = WS_S + 64 * MiB, WS_OG = WS_S + 96 * MiB, WS_HU1 = WS_S + 64 * MiB;
constexpr size_t WS_END = 512 * MiB;
constexpr size_t DO_KK = 0, DO_KKA = 48 * MiB, DO_ACT = 96 * MiB;

__device__ __forceinline__ unsigned cvtpk(float lo, float hi) { f32x2 v = {lo, hi}; bf16x2_t b = __builtin_convertvector(v, bf16x2_t); return __builtin_bit_cast(unsigned, b); }
__device__ __forceinline__ float bflo(unsigned w) { return __uint_as_float(w << 16); }
__device__ __forceinline__ float bfhi(unsigned w) { return __uint_as_float(w & 0xffff0000u); }
__device__ __forceinline__ float bf2f(bf16_t b) { return __uint_as_float(((unsigned)b) << 16); }
__device__ __forceinline__ bf16_t f2bf(float f) { return (bf16_t)(cvtpk(f, 0.f) & 0xffffu); }
__device__ __forceinline__ void unpack8(u32x4 w, float* o) { o[0] = bflo(w.x); o[1] = bfhi(w.x); o[2] = bflo(w.y); o[3] = bfhi(w.y); o[4] = bflo(w.z); o[5] = bfhi(w.z); o[6] = bflo(w.w); o[7] = bfhi(w.w); }
__device__ __forceinline__ u32x4 pack8(const float* v) { u32x4 w; w.x = cvtpk(v[0], v[1]); w.y = cvtpk(v[2], v[3]); w.z = cvtpk(v[4], v[5]); w.w = cvtpk(v[6], v[7]); return w; }
__device__ __forceinline__ float wave_sum(float v) {
#pragma unroll
    for (int o = 1; o < 64; o <<= 1) v += __shfl_xor(v, o);
    return v;
}
template <int CTRL> __device__ __forceinline__ float dpp_f(float x) { return __int_as_float(__builtin_amdgcn_update_dpp(0, __float_as_int(x), CTRL, 0xf, 0xf, true)); }
__device__ __forceinline__ float red8(float x) { x += dpp_f<0xB1>(x); x += dpp_f<0x4E>(x); x += dpp_f<0x141>(x); return x; }
__device__ __forceinline__ float sigmoidf_(float z) { return __builtin_amdgcn_rcpf(1.0f + __expf(-z)); }

namespace pg8 {
constexpr int BM = 256, BK = 64, HALF = 128, HTB = HALF * BK * 2, STAGE_BYTES = 8 * HTB, NXCD = 8, WGM = 8;
__host__ __device__ __forceinline__ int lds_byte(int r, int c) { const int st = (r >> 4) * 2 + (c >> 5), rr = r & 15, cc = c & 31, ob = rr * 64 + cc * 2; return st * 1024 + (ob ^ (((ob >> 9) & 1) << 5)); }
__host__ __device__ __forceinline__ void stage_rc(int b, int& R, int& C) { const int st = b / 1024, sb = b % 1024, swz = sb ^ (((sb >> 9) & 1) << 5); R = (st >> 1) * 16 + swz / 64; C = (st & 1) * 32 + (swz % 64) / 2; }
__host__ __device__ __forceinline__ int perm32(int rho) { const int n = rho >> 4, i = rho & 15; return 8 * (i >> 2) + 4 * n + (i & 3); }
struct Unit { int pm, pn; };
struct Gemm { const bf16_t* A; const bf16_t* Bt; int M, N, K; };
struct StaticOrder {
    int nM, nN, nwg, G, c;
    __device__ __forceinline__ void init(int M_, int N_, int G_, int c_) { nM = M_ / BM; nN = N_ / BM; nwg = nM * nN; G = G_; c = c_; }
    __device__ __forceinline__ bool next(int i, Unit& u) const {
        const long L = (long)i * G + c; if (L >= nwg) return false;
        int wgid = (int)L; { const int q = nwg / NXCD, r = nwg % NXCD, xcd = wgid % NXCD, off = wgid / NXCD; wgid = (xcd < r ? xcd * (q + 1) : r * (q + 1) + (xcd - r) * q) + off; }
        const int nig = WGM * nN, gid = wgid / nig, fm = gid * WGM, gsz = (nM - fm) < WGM ? (nM - fm) : WGM;
        u.pm = fm + ((wgid % nig) % gsz); u.pn = (wgid % nig) / gsz; return true;
    }
};
template <class Epi>
__device__ __forceinline__ void gemm_phase(LAS unsigned char* lds, const Gemm g, const StaticOrder& S, const Epi& E) {
    int tid = threadIdx.x; asm volatile("" : "+v"(tid));
    const int wid = __builtin_amdgcn_readfirstlane(tid >> 6), lane = tid & 63, wr = wid >> 2, wc = wid & 3, fr = lane & 15, fq = lane >> 4;
    int K_ = g.K; asm volatile("" : "+s"(K_));
    const int K = K_, nt = K / BK;
    unsigned voffA[2], voffB[2];
#pragma unroll
    for (int i = 0; i < 2; ++i) { int R, C; stage_rc(tid * 16 + i * 8192, R, C); const int Rb = Epi::PERM ? ((R & ~31) + perm32(R & 31)) : R;
        const int Ra = Epi::APERM ? (8 * (16 * (R >> 6) + (R & 15)) + ((R >> 4) & 3)) : R;
        voffA[i] = (unsigned)(Ra * K + C) * 2u; voffB[i] = (unsigned)(Rb * K + C) * 2u; }
    const size_t kstep = (size_t)(BK * 2);
    const size_t hstep = (size_t)HALF * K * 2;
    const size_t hstepA = Epi::APERM ? (size_t)4 * K * 2 : hstep;
    const size_t tstep = 2 * hstep;
    const unsigned ldsw = (unsigned)wid * 1024u;
    const int aoff = lds_byte(wr * 64 + fr, fq * 8), boff = lds_byte(wc * 32 + fr, fq * 8);
#define PG8_SA(b, h) (((b) * 2 + (h)) * HTB)
#define PG8_SB(b, h) ((4 + (b) * 2 + (h)) * HTB)
#define PG8_STAGE(bufoff, gbase, voff) do { _Pragma("unroll") for (int _i = 0; _i < 2; ++_i) \
        __builtin_amdgcn_global_load_lds((const unsigned*)((const char*)(gbase) + (voff)[_i]), (LAS unsigned*)(lds + (bufoff) + ldsw + _i * 8192), 16, 0, 0); } while (0)
#define PG8_LDA(dst, b, h) do { _Pragma("unroll") for (int m = 0; m < 4; ++m) _Pragma("unroll") for (int k = 0; k < 2; ++k) dst[m][k] = *(const LAS bf16x8*)(lds + PG8_SA(b, h) + aoff + m * 2048 + k * 1024); } while (0)
#define PG8_LDB(dst, b, h) do { _Pragma("unroll") for (int n = 0; n < 2; ++n) _Pragma("unroll") for (int k = 0; k < 2; ++k) dst[n][k] = *(const LAS bf16x8*)(lds + PG8_SB(b, h) + boff + n * 2048 + k * 1024); } while (0)
#define PG8_MMA(ai, bj, At, Bt) do { __builtin_amdgcn_s_setprio(1); _Pragma("unroll") for (int m = 0; m < 4; ++m) _Pragma("unroll") for (int n = 0; n < 2; ++n) _Pragma("unroll") for (int k = 0; k < 2; ++k) \
        acc[ai][bj][m][n] = __builtin_amdgcn_mfma_f32_16x16x32_bf16(Bt[n][k], At[m][k], acc[ai][bj][m][n], 0, 0, 0); __builtin_amdgcn_s_setprio(0); } while (0)
#define PG8_WAIT_V(n) asm volatile("s_waitcnt vmcnt(" #n ")" ::: "memory")
#define PG8_WAIT_L(n) asm volatile("s_waitcnt lgkmcnt(" #n ")" ::: "memory")
#define PG8_BAR __builtin_amdgcn_s_barrier()
#define PG8_SCHED __builtin_amdgcn_sched_barrier(0)
    Unit cur, nxt; int ui = 0;
    if (!S.next(0, cur)) return;
    f32x4 acc[2][2][4][2];
#pragma unroll
    for (int a = 0; a < 2; ++a)
#pragma unroll
        for (int b = 0; b < 2; ++b)
#pragma unroll
            for (int m = 0; m < 4; ++m)
#pragma unroll
                for (int n = 0; n < 2; ++n) acc[a][b][m][n] = (f32x4){0.f, 0.f, 0.f, 0.f};
    bf16x8 At[4][2], B0[2][2], B1[2][2];
    const char* cA = (const char*)g.A + (size_t)cur.pm * tstep; const char* cB = (const char*)g.Bt + (size_t)cur.pn * tstep;
    PG8_STAGE(PG8_SB(0, 0), cB, voffB); PG8_STAGE(PG8_SB(0, 1), cB + hstep, voffB); PG8_STAGE(PG8_SA(0, 0), cA, voffA); PG8_STAGE(PG8_SA(0, 1), cA + hstepA, voffA);
    if (wr == 1) PG8_BAR;
    PG8_WAIT_V(2); PG8_BAR;
    PG8_STAGE(PG8_SB(1, 0), cB + kstep, voffB); PG8_STAGE(PG8_SA(1, 0), cA + kstep, voffA); PG8_STAGE(PG8_SB(1, 1), cB + hstep + kstep, voffB);
    PG8_WAIT_V(6); PG8_BAR;
    for (;;) {
        const bool has_next = S.next(ui + 1, nxt);
        const char* nA = has_next ? (const char*)g.A + (size_t)nxt.pm * tstep : cA; const char* nB = has_next ? (const char*)g.Bt + (size_t)nxt.pn * tstep : cB;
        for (int t = 0; t < nt; t += 2) {
            const bool last = (t == nt - 2);
            const char* a1 = cA + (size_t)(t + 1) * kstep;
            const char* a2 = last ? nA : cA + (size_t)(t + 2) * kstep; const char* b2 = last ? nB : cB + (size_t)(t + 2) * kstep;
            const char* a3 = a2 + kstep; const char* b3 = b2 + kstep;
            PG8_LDB(B0, 0, 0); PG8_LDB(B1, 0, 1); PG8_SCHED; PG8_LDA(At, 0, 0); PG8_STAGE(PG8_SA(1, 1), a1 + hstepA, voffA);
            PG8_WAIT_V(8); PG8_WAIT_L(0); PG8_BAR; PG8_MMA(0, 0, At, B0); PG8_MMA(0, 1, At, B1); PG8_BAR; PG8_SCHED;
            PG8_LDA(At, 0, 1); PG8_STAGE(PG8_SB(0, 0), b2, voffB); PG8_STAGE(PG8_SB(0, 1), b2 + hstep, voffB); PG8_STAGE(PG8_SA(0, 0), a2, voffA);
            PG8_WAIT_V(8); PG8_WAIT_L(0); PG8_BAR; PG8_MMA(1, 0, At, B0); PG8_MMA(1, 1, At, B1); PG8_BAR; PG8_SCHED;
            PG8_LDB(B0, 1, 0); PG8_LDB(B1, 1, 1); PG8_SCHED; PG8_LDA(At, 1, 0); PG8_STAGE(PG8_SA(0, 1), a2 + hstepA, voffA);
            PG8_WAIT_V(8); PG8_WAIT_L(0); PG8_BAR; PG8_MMA(0, 0, At, B0); PG8_MMA(0, 1, At, B1); PG8_BAR; PG8_SCHED;
            PG8_LDA(At, 1, 1); PG8_STAGE(PG8_SB(1, 0), b3, voffB); PG8_STAGE(PG8_SB(1, 1), b3 + hstep, voffB); PG8_STAGE(PG8_SA(1, 0), a3, voffA);
            PG8_WAIT_V(8); PG8_WAIT_L(0); PG8_BAR; PG8_MMA(1, 0, At, B0); PG8_MMA(1, 1, At, B1); PG8_BAR; PG8_SCHED;
        }
        if (wr == 0) PG8_BAR;
        E(acc, cur, wr, wc, fr, fq);
        if (!has_next) break;
#pragma unroll
        for (int a = 0; a < 2; ++a)
#pragma unroll
            for (int b = 0; b < 2; ++b)
#pragma unroll
                for (int m = 0; m < 4; ++m)
#pragma unroll
                    for (int n = 0; n < 2; ++n) acc[a][b][m][n] = (f32x4){0.f, 0.f, 0.f, 0.f};
        cur = nxt; cA = nA; cB = nB; ++ui;
        if (wr == 1) PG8_BAR;
    }
    PG8_WAIT_V(0);
    PG8_BAR;
#undef PG8_SA
#undef PG8_SB
#undef PG8_STAGE
#undef PG8_LDA
#undef PG8_LDB
#undef PG8_MMA
#undef PG8_WAIT_V
#undef PG8_WAIT_L
#undef PG8_BAR
#undef PG8_SCHED
}
}
using pg8::Unit;

__device__ __forceinline__ float row_rs(const float* ssq, int row) {
    const f32x4* q = (const f32x4*)(ssq + (size_t)row * 16); const f32x4 a = q[0] + q[1] + q[2] + q[3];
    return rsqrtf(((a[0] + a[1]) + (a[2] + a[3])) * (1.f / D) + RMS_EPS);
}
#define ROW_SCALES8(sc, ssq_, ROWEXPR) do { f32x4 q_[8]; \
        _Pragma("unroll") for (int i_ = 0; i_ < 8; ++i_) q_[i_] = *(const f32x4*)((ssq_) + (size_t)(ROWEXPR) * 16 + 4 * fq); \
        _Pragma("unroll") for (int i_ = 0; i_ < 8; ++i_) { float s_ = (q_[i_][0] + q_[i_][1]) + (q_[i_][2] + q_[i_][3]); s_ += __shfl_xor(s_, 16); s_ += __shfl_xor(s_, 32); sc[i_] = rsqrtf(s_ * (1.f / D) + RMS_EPS); } } while (0)
struct EpiBf16 {
    static constexpr bool PERM = true, APERM = false;
    bf16_t* O; int ldc; const float* ssq;
    __device__ __forceinline__ void operator()(f32x4 (&acc)[2][2][4][2], const Unit& u, int wr, int wc, int fr, int fq) const {
        const int row0 = u.pm * 256 + wr * 64 + fr, col0 = u.pn * 256 + wc * 32 + 8 * fq;
        float scs[8];
#pragma unroll
        for (int i = 0; i < 8; ++i) scs[i] = ssq ? ssq[row0 + (i >> 2) * 128 + (i & 3) * 16] : 1.0f;
#pragma unroll
        for (int ai = 0; ai < 2; ++ai)
#pragma unroll
            for (int m = 0; m < 4; ++m) { const int row = row0 + ai * 128 + m * 16; bf16_t* rowp = O + (size_t)row * ldc + col0;
                const float sc = scs[ai * 4 + m];
#pragma unroll
                for (int bj = 0; bj < 2; ++bj) { const f32x4 v0 = acc[ai][bj][m][0] * sc, v1 = acc[ai][bj][m][1] * sc;
                    u32x4 w; w.x = cvtpk(v0[0], v0[1]); w.y = cvtpk(v0[2], v0[3]); w.z = cvtpk(v1[0], v1[1]); w.w = cvtpk(v1[2], v1[3]);
                    *(u32x4*)(rowp + bj * 128) = w; } }
    }
};
struct EpiResid {
    static constexpr bool PERM = true, APERM = false;
    const float* base; const bf16_t* baseb; float* out; bf16_t* XB; float* SSQ;
    __device__ __forceinline__ void operator()(f32x4 (&acc)[2][2][4][2], const Unit& u, int wr, int wc, int fr, int fq) const {
        const int row0 = u.pm * 256 + wr * 64 + fr, col0 = u.pn * 256 + wc * 32 + 8 * fq;
#pragma unroll
        for (int ai = 0; ai < 2; ++ai) {
            f32x4 bv[4][2][2];
#pragma unroll
            for (int m = 0; m < 4; ++m) { const size_t off = (size_t)(row0 + ai * 128 + m * 16) * D + col0;
#pragma unroll
                for (int bj = 0; bj < 2; ++bj) {
                    if (baseb) { const u32x4 w = *(const u32x4*)(baseb + off + bj * 128); bv[m][bj][0] = (f32x4){bflo(w.x), bfhi(w.x), bflo(w.y), bfhi(w.y)}; bv[m][bj][1] = (f32x4){bflo(w.z), bfhi(w.z), bflo(w.w), bfhi(w.w)}; }
                    else { bv[m][bj][0] = *(const f32x4*)(base + off + bj * 128); bv[m][bj][1] = *(const f32x4*)(base + off + bj * 128 + 4); } } }
            asm volatile("" ::: "memory");
#pragma unroll
            for (int m = 0; m < 4; ++m) { const int row = row0 + ai * 128 + m * 16; const size_t off = (size_t)row * D + col0; float ss = 0.f;
#pragma unroll
                for (int bj = 0; bj < 2; ++bj) {
                    const f32x4 o0 = bv[m][bj][0] + acc[ai][bj][m][0], o1 = bv[m][bj][1] + acc[ai][bj][m][1];
                    if (out) { __builtin_nontemporal_store(o0, (f32x4*)(out + off + bj * 128)); __builtin_nontemporal_store(o1, (f32x4*)(out + off + bj * 128 + 4)); }
                    if (XB) { u32x4 w; w.x = cvtpk(o0[0], o0[1]); w.y = cvtpk(o0[2], o0[3]); w.z = cvtpk(o1[0], o1[1]); w.w = cvtpk(o1[2], o1[3]); *(u32x4*)(XB + off + bj * 128) = w;
                        ss += (o0[0] * o0[0] + o0[1] * o0[1]) + (o0[2] * o0[2] + o0[3] * o0[3]) + (o1[0] * o1[0] + o1[1] * o1[1]) + (o1[2] * o1[2] + o1[3] * o1[3]); } }
                if (XB) { ss += __shfl_xor(ss, 16); ss += __shfl_xor(ss, 32); if (fq == 0) SSQ[(size_t)row * 16 + u.pn * 4 + wc] = ss; } }
            asm volatile("" ::: "memory");
        }
    }
};
struct EpiLora {
    static constexpr bool PERM = true, APERM = false;
    const float *w0, *a0; unsigned short* WL; bf16_t* AB; bf16_t* G;
    __device__ __forceinline__ void operator()(f32x4 (&acc)[2][2][4][2], const Unit& u, int wr, int wc, int fr, int fq) const {
        const int kind = u.pn / 3, row0 = u.pm * 256 + wr * 64 + fr;
#pragma unroll
        for (int bj = 0; bj < 2; ++bj) {
            const int c = (u.pn % 3) * 256 + bj * 128 + wc * 32 + 8 * fq;
            if (kind == 2) {
#pragma unroll
                for (int ai = 0; ai < 2; ++ai)
#pragma unroll
                    for (int m = 0; m < 4; ++m) { const int row = row0 + ai * 128 + m * 16; const f32x4 v0 = acc[ai][bj][m][0], v1 = acc[ai][bj][m][1];
                        u32x4 w; w.x = cvtpk(v0[0], v0[1]); w.y = cvtpk(v0[2], v0[3]); w.z = cvtpk(v1[0], v1[1]); w.w = cvtpk(v1[2], v1[3]);
                        *(u32x4*)(G + (size_t)row * RW + c) = w; }
            } else {
                const float* bp = (kind == 0 ? w0 : a0) + c;
                const f32x4 b0 = *(const f32x4*)bp, b1 = *(const f32x4*)(bp + 4);
#pragma unroll
                for (int ai = 0; ai < 2; ++ai)
#pragma unroll
                    for (int m = 0; m < 4; ++m) { const int row = row0 + ai * 128 + m * 16; float sg[8];
#pragma unroll
                        for (int j = 0; j < 4; ++j) { sg[j] = sigmoidf_(b0[j] + acc[ai][bj][m][0][j]); sg[4 + j] = sigmoidf_(b1[j] + acc[ai][bj][m][1][j]); }
                        if (kind == 0) { unsigned short h[8];
#pragma unroll
                            for (int j = 0; j < 8; ++j) h[j] = __builtin_bit_cast(unsigned short, (_Float16)(-0.60653066f * sg[j]));
                            u32x4 w; w.x = h[0] | ((unsigned)h[1] << 16); w.y = h[2] | ((unsigned)h[3] << 16); w.z = h[4] | ((unsigned)h[5] << 16); w.w = h[6] | ((unsigned)h[7] << 16);
                            *(u32x4*)(WL + (size_t)row * RW + c) = w; }
                        else *(u32x4*)(AB + (size_t)row * RW + c) = pack8(sg); }
            }
        }
    }
};
struct EpiFFN {
    static constexpr bool PERM = true, APERM = true;
    const float* cw; const float* cb; bf16_t* Z; float* HU; const float* ssq;
    template <int n> __device__ __forceinline__ void half(f32x4 (&acc)[2][2][4][2], const f32x4 (&prm)[2][8], const Unit& u, int wr, int wc, int fr, int fq) const {
        const int rowb = u.pm * 256 + 8 * (16 * wr + fr);
        const int grp = u.pm * 2 + wr;
        const int c = u.pn * 128 + wc * 32 + 8 * fq + 4 * n;
        const f32x4 g0 = prm[n][0], g1 = prm[n][1], g2 = prm[n][2], gb = prm[n][3], v0 = prm[n][4], v1 = prm[n][5], v2 = prm[n][6], vb = prm[n][7];
        f32x4 pg6, pg7, pv6, pv7;
#pragma unroll
        for (int j = 0; j < 4; ++j) { pg6[j] = dpp_f<0x111>(acc[1][0][2][n][j]); pg7[j] = dpp_f<0x111>(acc[1][0][3][n][j]); pv6[j] = dpp_f<0x111>(acc[1][1][2][n][j]); pv7[j] = dpp_f<0x111>(acc[1][1][3][n][j]); }
        if (fr == 0) {
            float* h = HU + ((size_t)grp * 4) * FF2;
            *(f32x4*)(h + c) = acc[0][0][0][n]; *(f32x4*)(h + FF + c) = acc[0][1][0][n]; *(f32x4*)(h + FF2 + c) = acc[0][0][1][n]; *(f32x4*)(h + FF2 + FF + c) = acc[0][1][1][n]; }
        if (fr == 15) {
            float* h = HU + ((size_t)grp * 4 + 2) * FF2;
            *(f32x4*)(h + c) = acc[1][0][2][n]; *(f32x4*)(h + FF + c) = acc[1][1][2][n]; *(f32x4*)(h + FF2 + c) = acc[1][0][3][n]; *(f32x4*)(h + FF2 + FF + c) = acc[1][1][3][n]; }
#define FFN_ROW(i, UG, UV, UG1, UV1, UG2, UV2) { const f32x4 cgv = gb + g0 * (UG2) + g1 * (UG1) + g2 * (UG), cvv = vb + v0 * (UV2) + v1 * (UV1) + v2 * (UV); \
            if ((i) >= 2 || fr != 0) { u32x2 w; w.x = cvtpk(cgv[0] * sigmoidf_(cgv[0]) * cvv[0], cgv[1] * sigmoidf_(cgv[1]) * cvv[1]); w.y = cvtpk(cgv[2] * sigmoidf_(cgv[2]) * cvv[2], cgv[3] * sigmoidf_(cgv[3]) * cvv[3]); \
                *(u32x2*)(Z + (size_t)(rowb + (i)) * FF + c) = w; } }
        FFN_ROW(0, acc[0][0][0][n], acc[0][1][0][n], pg7, pv7, pg6, pv6)
        FFN_ROW(1, acc[0][0][1][n], acc[0][1][1][n], acc[0][0][0][n], acc[0][1][0][n], pg7, pv7)
        FFN_ROW(2, acc[0][0][2][n], acc[0][1][2][n], acc[0][0][1][n], acc[0][1][1][n], acc[0][0][0][n], acc[0][1][0][n])
        FFN_ROW(3, acc[0][0][3][n], acc[0][1][3][n], acc[0][0][2][n], acc[0][1][2][n], acc[0][0][1][n], acc[0][1][1][n])
        FFN_ROW(4, acc[1][0][0][n], acc[1][1][0][n], acc[0][0][3][n], acc[0][1][3][n], acc[0][0][2][n], acc[0][1][2][n])
        FFN_ROW(5, acc[1][0][1][n], acc[1][1][1][n], acc[1][0][0][n], acc[1][1][0][n], acc[0][0][3][n], acc[0][1][3][n])
        FFN_ROW(6, acc[1][0][2][n], acc[1][1][2][n], acc[1][0][1][n], acc[1][1][1][n], acc[1][0][0][n], acc[1][1][0][n])
        FFN_ROW(7, acc[1][0][3][n], acc[1][1][3][n], acc[1][0][2][n], acc[1][1][2][n], acc[1][0][1][n], acc[1][1][1][n])
#undef FFN_ROW
    }
    __device__ __forceinline__ void operator()(f32x4 (&acc)[2][2][4][2], const Unit& u, int wr, int wc, int fr, int fq) const {
        f32x4 prm[2][8];
#pragma unroll
        for (int n = 0; n < 2; ++n) { const int c = u.pn * 128 + wc * 32 + 8 * fq + 4 * n;
            prm[n][0] = *(const f32x4*)(cw + c); prm[n][1] = *(const f32x4*)(cw + FF2 + c); prm[n][2] = *(const f32x4*)(cw + 2 * FF2 + c); prm[n][3] = *(const f32x4*)(cb + c);
            prm[n][4] = *(const f32x4*)(cw + FF + c); prm[n][5] = *(const f32x4*)(cw + FF2 + FF + c); prm[n][6] = *(const f32x4*)(cw + 2 * FF2 + FF + c); prm[n][7] = *(const f32x4*)(cb + FF + c); }
        if (ssq) { const int rowb = u.pm * 256 + 8 * (16 * wr + fr);
            const f32x4 sA = *(const f32x4*)(ssq + rowb), sB = *(const f32x4*)(ssq + rowb + 4);
            const float sc[8] = {sA[0], sA[1], sA[2], sA[3], sB[0], sB[1], sB[2], sB[3]};
#pragma unroll
            for (int i = 0; i < 8; ++i)
#pragma unroll
                for (int bj = 0; bj < 2; ++bj)
#pragma unroll
                    for (int n = 0; n < 2; ++n) acc[i >> 2][bj][i & 3][n] *= sc[i]; }
        half<0>(acc, prm, u, wr, wc, fr, fq); half<1>(acc, prm, u, wr, wc, fr, fq);
    }
};

struct Params { const float* in[31]; float* out; unsigned char* ws; int ph_lo, ph_hi; };
enum { I_X = 0, I_MEM, I_ATTN_NORM, I_A_W_IN, I_A_MU, I_A_W0, I_A_W2, I_A_A0, I_A_A2, I_A_G2, I_A_K_K, I_A_K_A, I_A_R_K, I_A_LNX_W, I_A_LNX_B, I_A_W_OUT,
       I_KV_NORM, I_KV_W, I_KV_K_NORM, I_B_W_IN, I_B_Q_NORM, I_B_W_OUT, I_MEM_NORM, I_MEM_W_KV, I_MEM_Q_NORM, I_MEM_K_NORM, I_FFN_NORM, I_FFN_W_UP, I_FFN_CONV_W, I_FFN_CONV_B, I_FFN_W_DOWN };

__device__ __forceinline__ void tr_item(const float* W, int N, const float* gain, bf16_t* WT, int ldk, int koff, int drow0, int k0, int n0, LAS float* scr, int lane) {
    float wv[32];
#pragma unroll
    for (int i = 0; i < 32; ++i) { const int kk = 2 * i + (lane >> 5); wv[i] = __builtin_nontemporal_load(W + (size_t)(k0 + kk) * N + n0 + (lane & 31)); }
    if (gain) {
#pragma unroll
        for (int i = 0; i < 32; ++i) wv[i] *= gain[k0 + 2 * i + (lane >> 5)]; }
#pragma unroll
    for (int i = 0; i < 32; ++i) { const int kk = 2 * i + (lane >> 5); scr[kk * 33 + (lane & 31)] = wv[i]; }
    asm volatile("s_waitcnt lgkmcnt(0)" ::: "memory");
    const int c = lane & 7;
#pragma unroll
    for (int j = 0; j < 4; ++j) { const int n = (lane >> 3) + 8 * j; const LAS float* s = scr + (8 * c) * 33 + n;
        u32x4 o; o.x = cvtpk(s[0 * 33], s[1 * 33]); o.y = cvtpk(s[2 * 33], s[3 * 33]); o.z = cvtpk(s[4 * 33], s[5 * 33]); o.w = cvtpk(s[6 * 33], s[7 * 33]);
        *(u32x4*)(WT + (size_t)(drow0 + n) * ldk + koff + k0 + 8 * c) = o; }
    asm volatile("s_waitcnt lgkmcnt(0)" ::: "memory");
}
__device__ __forceinline__ void rms_row_to_bf16(const float* xrow, bf16_t* orow, int lane) {
    const f32x4* xr = (const f32x4*)xrow + lane;
    f32x4 v[4]; float s = 0.f;
#pragma unroll
    for (int j = 0; j < 4; ++j) { v[j] = xr[64 * j]; s += (v[j].x * v[j].x + v[j].y * v[j].y) + (v[j].z * v[j].z + v[j].w * v[j].w); }
    const float rs = rsqrtf(wave_sum(s) * (1.f / D) + RMS_EPS);
    u32x2* o8 = (u32x2*)orow + lane;
#pragma unroll
    for (int j = 0; j < 4; ++j) { u32x2 w; w.x = cvtpk(v[j].x * rs, v[j].y * rs); w.y = cvtpk(v[j].z * rs, v[j].w * rs); o8[64 * j] = w; }
}
__device__ __forceinline__ void rms_pass(const float* X, bf16_t* O, int rows, int gw, int ngw, int lane_, float* RSout = nullptr) {
    int lane = lane_; asm volatile("" : "+v"(lane));
    for (int m0 = gw * 4; m0 < rows; m0 += ngw * 4) {
        f32x4 v[4][4]; float s[4];
#pragma unroll
        for (int u = 0; u < 4; ++u) { const f32x4* xr = (const f32x4*)(X + (size_t)(m0 + u) * D) + lane;
#pragma unroll
            for (int j = 0; j < 4; ++j) v[u][j] = __builtin_nontemporal_load(xr + 64 * j); }
#pragma unroll
        for (int u = 0; u < 4; ++u) { s[u] = 0.f;
#pragma unroll
            for (int j = 0; j < 4; ++j) s[u] += (v[u][j].x * v[u][j].x + v[u][j].y * v[u][j].y) + (v[u][j].z * v[u][j].z + v[u][j].w * v[u][j].w); }
#pragma unroll
        for (int o = 1; o < 64; o <<= 1) {
#pragma unroll
            for (int u = 0; u < 4; ++u) s[u] += __shfl_xor(s[u], o); }
#pragma unroll
        for (int u = 0; u < 4; ++u) { float rs = rsqrtf(s[u] * (1.f / D) + RMS_EPS); if (RSout) { if (lane == 0) RSout[m0 + u] = rs; rs = 1.0f; } u32x2* o8 = (u32x2*)(O + (size_t)(m0 + u) * D) + lane;
#pragma unroll
            for (int j = 0; j < 4; ++j) { u32x2 w; w.x = cvtpk(v[u][j].x * rs, v[u][j].y * rs); w.y = cvtpk(v[u][j].z * rs, v[u][j].w * rs); o8[64 * j] = w; } }
    }
}

constexpr int KS_STRIDE = 144, VT_STRIDE = 528, KS_BYTES = 256 * KS_STRIDE, VT_BYTES = 64 * VT_STRIDE;
struct AttnDesc { const bf16_t* Qb; const bf16_t* Kb; const bf16_t* Vb; bf16_t* Ob; float* lse; const float* qgain; const float* kgain; int qpitch, kvpitch, opitch, rho, d, n; };
struct AttnRaw { u32x4 k1a, k2a, k1b, k2b, v0, v1, v2, v3, q1, q2; };
template <bool DIL>
__device__ __forceinline__ void attn_issue(const AttnDesc& a, AttnRaw& R, int tid) {
    const u32x4 z = (u32x4){0u, 0u, 0u, 0u};
#define AT_KLD(it_, K1, K2) do { const int item = tid + 512 * (it_), jj = item >> 2, c = item & 3; const int sub = DIL ? (a.n - 1) * 128 + jj : jj; const int pos = DIL ? a.rho + a.d * sub : jj; \
        K1 = z; K2 = z; if (sub >= 0) { const bf16_t* kp = a.Kb + (size_t)pos * a.kvpitch; K1 = *(const u32x4*)(kp + c * 8); K2 = *(const u32x4*)(kp + 32 + c * 8); } } while (0)
#define AT_VLD(it_, V) do { const int item = tid + 512 * (it_), jj = item >> 3, c = item & 7; const int sub = DIL ? (a.n - 1) * 128 + jj : jj; const int pos = DIL ? a.rho + a.d * sub : jj; \
        V = z; if (sub >= 0) V = *(const u32x4*)(a.Vb + (size_t)pos * a.kvpitch + c * 8); } while (0)
    AT_KLD(0, R.k1a, R.k2a); AT_KLD(1, R.k1b, R.k2b); AT_VLD(0, R.v0); AT_VLD(1, R.v1); AT_VLD(2, R.v2); AT_VLD(3, R.v3);
#undef AT_KLD
#undef AT_VLD
    { const int wave = tid >> 6, lane = tid & 63, iq = 16 * wave + (lane & 15), Q = lane >> 4; const int qpos = DIL ? a.rho + a.d * (a.n * 128 + iq) : a.n * 128 + iq;
      const bf16_t* qp = a.Qb + (size_t)qpos * a.qpitch; R.q1 = *(const u32x4*)(qp + Q * 8); R.q2 = *(const u32x4*)(qp + 32 + Q * 8); }
}
template <bool DIL>
__device__ __forceinline__ void attn_body(LAS unsigned char* lds, const AttnDesc& a, AttnRaw& R, const float* rope, bool has_next, const AttnDesc& nxt) {
    constexpr int NT = DIL ? 10 : 16;
    int tid = threadIdx.x; asm volatile("" : "+v"(tid));
    const int wave = tid >> 6, lane = tid & 63, lr = lane & 15, Q = lane >> 4;
    const int rho = a.rho, d = a.d, n = a.n; const float* kgain = a.kgain; const float* qgain = a.qgain;
    LAS unsigned char* Ks = lds; LAS unsigned char* Vt = lds + KS_BYTES;
#define AT_KST(it_, K1, K2) do { const int item = tid + 512 * (it_), jj = item >> 2, c = item & 3; \
        const int sub = DIL ? (n - 1) * 128 + jj : jj; const bool valid = sub >= 0; const int pos = DIL ? rho + d * sub : jj; \
        float x1[8], x2[8]; unpack8(K1, x1); unpack8(K2, x2); \
        float ss = 0.f; \
        _Pragma("unroll") for (int i = 0; i < 8; ++i) ss += x1[i] * x1[i] + x2[i] * x2[i]; \
        ss += __shfl_xor(ss, 1); ss += __shfl_xor(ss, 2); \
        const float rs = rsqrtf(ss * (1.f / 64.f) + RMS_EPS); \
        float o1[8], o2[8], g1[8], g2[8], cs[8], sn[8]; \
        *(f32x4*)g1 = *(const f32x4*)(kgain + c * 8); *(f32x4*)(g1 + 4) = *(const f32x4*)(kgain + c * 8 + 4); *(f32x4*)g2 = *(const f32x4*)(kgain + 32 + c * 8); *(f32x4*)(g2 + 4) = *(const f32x4*)(kgain + 32 + c * 8 + 4); \
        if (DIL) { const int pz = valid ? pos : 0; *(f32x4*)cs = *(const f32x4*)(rope + pz * 32 + c * 8); *(f32x4*)(cs + 4) = *(const f32x4*)(rope + pz * 32 + c * 8 + 4); \
            *(f32x4*)sn = *(const f32x4*)(rope + T * 32 + pz * 32 + c * 8); *(f32x4*)(sn + 4) = *(const f32x4*)(rope + T * 32 + pz * 32 + c * 8 + 4); } \
        _Pragma("unroll") for (int i = 0; i < 8; ++i) { const float aa = x1[i] * rs * g1[i], bb = x2[i] * rs * g2[i]; \
            if (DIL) { o1[i] = aa * cs[i] - bb * sn[i]; o2[i] = bb * cs[i] + aa * sn[i]; } else { o1[i] = aa; o2[i] = bb; } } \
        *(LAS u32x4*)(Ks + jj * KS_STRIDE + c * 16) = pack8(o1); *(LAS u32x4*)(Ks + jj * KS_STRIDE + 64 + c * 16) = pack8(o2); } while (0)
    AT_KST(0, R.k1a, R.k2a); AT_KST(1, R.k1b, R.k2b);
#undef AT_KST
#define AT_VST(it_, V) do { const int item = tid + 512 * (it_), jj = item >> 3, c = item & 7; const unsigned ww[4] = {V.x, V.y, V.z, V.w}; \
        _Pragma("unroll") for (int i = 0; i < 4; ++i) { *(LAS unsigned short*)(Vt + (c * 8 + 2 * i) * VT_STRIDE + jj * 2) = (unsigned short)(ww[i] & 0xffffu); *(LAS unsigned short*)(Vt + (c * 8 + 2 * i + 1) * VT_STRIDE + jj * 2) = (unsigned short)(ww[i] >> 16); } } while (0)
    AT_VST(0, R.v0); AT_VST(1, R.v1); AT_VST(2, R.v2); AT_VST(3, R.v3);
#undef AT_VST
    constexpr int NQ = DIL ? 1 : 4;
    const int iq = 16 * wave + lr;
    bf16_t* Ob = a.Ob; const int opitch = a.opitch; float* lse = a.lse;
    for (int nn = 0; nn < NQ; ++nn) {
    const int qpos = DIL ? rho + d * (n * 128 + iq) : (n + nn) * 128 + iq;
    bf16x8 bq1, bq2;
    { float x1[8], x2[8]; unpack8(R.q1, x1); unpack8(R.q2, x2);
      float ss = 0.f;
#pragma unroll
      for (int i = 0; i < 8; ++i) ss += x1[i] * x1[i] + x2[i] * x2[i];
      ss += __shfl_xor(ss, 16); ss += __shfl_xor(ss, 32);
      const float rs = rsqrtf(ss * (1.f / 64.f) + RMS_EPS);
      float o1[8], o2[8], g1[8], g2[8], cs[8], sn[8];
      *(f32x4*)g1 = *(const f32x4*)(qgain + Q * 8); *(f32x4*)(g1 + 4) = *(const f32x4*)(qgain + Q * 8 + 4); *(f32x4*)g2 = *(const f32x4*)(qgain + 32 + Q * 8); *(f32x4*)(g2 + 4) = *(const f32x4*)(qgain + 32 + Q * 8 + 4);
      if (DIL) { *(f32x4*)cs = *(const f32x4*)(rope + qpos * 32 + Q * 8); *(f32x4*)(cs + 4) = *(const f32x4*)(rope + qpos * 32 + Q * 8 + 4);
          *(f32x4*)sn = *(const f32x4*)(rope + T * 32 + qpos * 32 + Q * 8); *(f32x4*)(sn + 4) = *(const f32x4*)(rope + T * 32 + qpos * 32 + Q * 8 + 4); }
#pragma unroll
      for (int i = 0; i < 8; ++i) { const float aa = x1[i] * rs * g1[i], bb = x2[i] * rs * g2[i];
          if (DIL) { o1[i] = (aa * cs[i] - bb * sn[i]) * 0.125f; o2[i] = (bb * cs[i] + aa * sn[i]) * 0.125f; }
          else { o1[i] = aa * 0.125f; o2[i] = bb * 0.125f; } }
      bq1 = __builtin_bit_cast(bf16x8, pack8(o1)); bq2 = __builtin_bit_cast(bf16x8, pack8(o2)); }
    if (nn == 0) { asm volatile("s_waitcnt lgkmcnt(0)" ::: "memory"); __builtin_amdgcn_s_barrier(); asm volatile("" ::: "memory"); }
    if (nn + 1 < NQ) { const bf16_t* qp = a.Qb + (size_t)(qpos + 128) * a.qpitch; R.q1 = *(const u32x4*)(qp + Q * 8); R.q2 = *(const u32x4*)(qp + 32 + Q * 8); }
    else if (has_next) attn_issue<DIL>(nxt, R, tid);
    const int kt0 = DIL ? (wave < 6 ? wave : 6) : 0;
    f32x4 s[NT];
#pragma unroll
    for (int kt = 0; kt < NT; ++kt) { const LAS unsigned char* kp = Ks + (16 * (kt0 + kt) + lr) * KS_STRIDE + Q * 16;
        const bf16x8 a1 = *(const LAS bf16x8*)kp, a2 = *(const LAS bf16x8*)(kp + 64);
        f32x4 z = (f32x4){0.f, 0.f, 0.f, 0.f};
        z = __builtin_amdgcn_mfma_f32_16x16x32_bf16(a1, bq1, z, 0, 0, 0); s[kt] = __builtin_amdgcn_mfma_f32_16x16x32_bf16(a2, bq2, z, 0, 0, 0); }
    float mx = -3.0e38f;
#pragma unroll
    for (int kt = 0; kt < NT; ++kt)
#pragma unroll
        for (int j = 0; j < 4; ++j) { if (DIL) { const int jj = 16 * (kt0 + kt) + 4 * Q + j; const bool ok = (jj >= iq) && (jj <= iq + 128) && (n > 0 || jj >= 128); if (!ok) s[kt][j] = -1e30f; } mx = fmaxf(mx, s[kt][j]); }
    mx = fmaxf(mx, __shfl_xor(mx, 16)); mx = fmaxf(mx, __shfl_xor(mx, 32));
    float den = 0.f;
#pragma unroll
    for (int kt = 0; kt < NT; ++kt)
#pragma unroll
        for (int j = 0; j < 4; ++j) { const float e = __expf(s[kt][j] - mx); s[kt][j] = e; den += e; }
    den += __shfl_xor(den, 16); den += __shfl_xor(den, 32);
    f32x4 o[4];
#pragma unroll
    for (int dt = 0; dt < 4; ++dt) o[dt] = (f32x4){0.f, 0.f, 0.f, 0.f};
#pragma unroll
    for (int p2 = 0; p2 < NT / 2; ++p2) {
        u32x4 pb; pb.x = cvtpk(s[2 * p2][0], s[2 * p2][1]); pb.y = cvtpk(s[2 * p2][2], s[2 * p2][3]); pb.z = cvtpk(s[2 * p2 + 1][0], s[2 * p2 + 1][1]); pb.w = cvtpk(s[2 * p2 + 1][2], s[2 * p2 + 1][3]);
        const bf16x8 b = __builtin_bit_cast(bf16x8, pb);
#pragma unroll
        for (int dt = 0; dt < 4; ++dt) { const LAS unsigned char* vp = Vt + (16 * dt + lr) * VT_STRIDE + (16 * (kt0 + 2 * p2) + 4 * Q) * 2;
            const u32x2 lo = *(const LAS u32x2*)vp, hi = *(const LAS u32x2*)(vp + 32);
            const u32x4 av = (u32x4){lo.x, lo.y, hi.x, hi.y};
            o[dt] = __builtin_amdgcn_mfma_f32_16x16x32_bf16(__builtin_bit_cast(bf16x8, av), b, o[dt], 0, 0, 0); }
    }
    const float inv = __builtin_amdgcn_rcpf(den);
    bf16_t* op = Ob + (size_t)qpos * opitch;
#pragma unroll
    for (int dt = 0; dt < 4; ++dt) { u32x2 w; w.x = cvtpk(o[dt][0] * inv, o[dt][1] * inv); w.y = cvtpk(o[dt][2] * inv, o[dt][3] * inv); *(u32x2*)(op + 16 * dt + 4 * Q) = w; }
    if (DIL && Q == 0) lse[(size_t)qpos * 4] = mx + __logf(den);
    }
    asm volatile("s_waitcnt lgkmcnt(0)" ::: "memory"); __builtin_amdgcn_s_barrier(); asm volatile("" ::: "memory");
}

constexpr int TC = 32;
__device__ __forceinline__ float red16(float x) { x += dpp_f<0xB1>(x); x += dpp_f<0x4E>(x); x += dpp_f<0x141>(x); x += dpp_f<0x140>(x); return x; }
struct ScanOps { f32x4 kk, w, ka, k, r; float v; };
__device__ __forceinline__ float h2f(unsigned short h) { return (float)__builtin_bit_cast(_Float16, h); }
__device__ __forceinline__ void scan_half(LAS unsigned char* lds, int hb, const bf16_t* P, const unsigned short* WL, const bf16_t* AB, const bf16_t* KKb,
                                          const float* mu, const float* k_a, const float* r_k, float* RK, bf16_t* Y) {
    int tid = threadIdx.x; asm volatile("" : "+v"(tid));
    const int wave = __builtin_amdgcn_readfirstlane(tid >> 6), lane = tid & 63;
    const int hh = hb >> 1, half = hb & 1, b = hh / 12, h = hh % 12;
    const size_t tok0 = (size_t)b * T;
    LAS float* bufs = (LAS float*)lds;
    LAS float* vbuf = (LAS float*)(lds + 81920 + 1024);
    LAS float* ys = (LAS float*)(lds + 81920 + 1024 + 8192 + 1024);
    constexpr int NCH = T / TC;
    const int sel = tid >> 8, li = tid & 255, lrow = li >> 3, c8 = (li & 7) * 8, ch = h * 64 + c8;
    const int lrv = (li >> 2) & 31, cv = 1536 + h * 64 + 32 * half + (li & 3) * 8;
    float m0[8], m1[8], ka8[8], rk8[8];
    { const float* pa = sel ? mu + cv : mu + ch; *(f32x4*)m0 = *(const f32x4*)pa; *(f32x4*)(m0 + 4) = *(const f32x4*)(pa + 4); }
    *(f32x4*)m1 = *(const f32x4*)(mu + RW + ch); *(f32x4*)(m1 + 4) = *(const f32x4*)(mu + RW + ch + 4);
    *(f32x4*)ka8 = *(const f32x4*)(k_a + ch); *(f32x4*)(ka8 + 4) = *(const f32x4*)(k_a + ch + 4);
    *(f32x4*)rk8 = *(const f32x4*)(r_k + ch); *(f32x4*)(rk8 + 4) = *(const f32x4*)(r_k + ch + 4);
    u32x4 q0, q1, q2, q3, q4, q5;
    const bool vthr = (sel == 1) && (li < 128);
#define SCAN_ISSUE(cc_) do { const size_t tok = tok0 + (size_t)(cc_) * TC + lrow; const size_t tokp = ((cc_) == 0 && lrow == 0) ? tok : tok - 1; \
        if (sel == 0) { q0 = *(const u32x4*)(P + tok * AIN + ch); q1 = *(const u32x4*)(P + tokp * AIN + ch); q2 = *(const u32x4*)(P + tok * AIN + RW + ch); q3 = *(const u32x4*)(P + tokp * AIN + RW + ch); \
            q4 = *(const u32x4*)(AB + tok * RW + ch); q5 = *(const u32x4*)(KKb + tok * RW + ch); } \
        else { q0 = *(const u32x4*)(WL + tok * RW + ch); \
            if (vthr) { const size_t tv = tok0 + (size_t)(cc_) * TC + lrv; const size_t tvp = ((cc_) == 0 && lrv == 0) ? tv : tv - 1; q1 = *(const u32x4*)(P + tv * AIN + cv); q2 = *(const u32x4*)(P + tvp * AIN + cv); } } } while (0)
#define ST8(dst, a) do { *(LAS f32x4*)(dst) = (f32x4){a[0], a[1], a[2], a[3]}; *(LAS f32x4*)((dst) + 4) = (f32x4){a[4], a[5], a[6], a[7]}; } while (0)
#define SCAN_COMMIT(cc_) do { LAS float* bb_ = bufs + ((cc_) & 1) * 5 * (TC * 64) + lrow * 64 + c8; \
        if (sel == 0) { const bool z_ = ((cc_) == 0 && lrow == 0); float pc[8], pp[8], rr[8], kr[8], av[8], kk[8], o[8]; \
            unpack8(q0, pc); unpack8(q1, pp); \
            _Pragma("unroll") for (int j = 0; j < 8; ++j) { const float pv = z_ ? 0.f : pp[j]; rr[j] = pc[j] + (pv - pc[j]) * m0[j]; } \
            ST8(bb_, rr); \
            unpack8(q2, pc); unpack8(q3, pp); unpack8(q4, av); unpack8(q5, kk); \
            float rks = 0.f; \
            _Pragma("unroll") for (int j = 0; j < 8; ++j) { const float pv = z_ ? 0.f : pp[j]; const float kx = pc[j] + (pv - pc[j]) * m1[j]; kr[j] = kx * (1.0f + (av[j] - 1.0f) * ka8[j]); o[j] = kk[j] * av[j]; rks += rr[j] * kr[j] * rk8[j]; } \
            ST8(bb_ + 2 * TC * 64, kr); ST8(bb_ + 3 * TC * 64, kk); ST8(bb_ + 4 * TC * 64, o); \
            rks = red8(rks); \
            if (half == 0 && (li & 7) == 0) RK[(tok0 + (size_t)(cc_) * TC + lrow) * 12 + h] = rks; \
        } else { float o[8]; \
            o[0] = __expf(h2f((unsigned short)(q0.x & 0xffffu))); o[1] = __expf(h2f((unsigned short)(q0.x >> 16))); o[2] = __expf(h2f((unsigned short)(q0.y & 0xffffu))); o[3] = __expf(h2f((unsigned short)(q0.y >> 16))); \
            o[4] = __expf(h2f((unsigned short)(q0.z & 0xffffu))); o[5] = __expf(h2f((unsigned short)(q0.z >> 16))); o[6] = __expf(h2f((unsigned short)(q0.w & 0xffffu))); o[7] = __expf(h2f((unsigned short)(q0.w >> 16))); \
            ST8(bb_ + 1 * TC * 64, o); \
            if (vthr) { const bool zv_ = ((cc_) == 0 && lrv == 0); float pc[8], pp[8]; unpack8(q1, pc); unpack8(q2, pp); \
                _Pragma("unroll") for (int j = 0; j < 8; ++j) { const float pv = zv_ ? 0.f : pp[j]; o[j] = pc[j] + (pv - pc[j]) * m0[j]; } \
                LAS float* vb_ = vbuf + ((cc_) & 1) * TC * 32 + lrv * 32 + (li & 3) * 8; ST8(vb_, o); } } } while (0)
    const int rg = lane >> 4, kl = lane & 15, row32 = wave * 4 + rg;
    f32x4 S = (f32x4){0.f, 0.f, 0.f, 0.f};
    SCAN_ISSUE(0); SCAN_COMMIT(0); __syncthreads();
    for (int chunk = 0; chunk < NCH; ++chunk) {
        if (chunk + 1 < NCH) SCAN_ISSUE(chunk + 1);
        const LAS float* bb = bufs + (chunk & 1) * 5 * TC * 64 + kl * 4;
        const LAS float* vb = vbuf + (chunk & 1) * TC * 32 + row32;
#define SCAN_LD(X, t) do { const LAS float* q_ = bb + (t) * 64; X.kk = *(const LAS f32x4*)(q_ + 3 * TC * 64); X.w = *(const LAS f32x4*)(q_ + 1 * TC * 64); X.ka = *(const LAS f32x4*)(q_ + 4 * TC * 64); \
            X.k = *(const LAS f32x4*)(q_ + 2 * TC * 64); X.r = *(const LAS f32x4*)(q_); X.v = vb[(t) * 32]; } while (0)
#define SCAN_STEP(X, yout) do { const f32x4 pa_ = S * X.kk; const f32x2 pq_ = pa_.xy + pa_.zw; float sa_ = pq_.x + pq_.y; sa_ = -red16(sa_); \
            S = S * X.w + (X.ka * sa_ + X.k * X.v); \
            const f32x4 py_ = S * X.r; const f32x2 pr_ = py_.xy + py_.zw; const float y_ = pr_.x + pr_.y; yout = red16(y_); } while (0)
        ScanOps X0, X1;
        SCAN_LD(X0, 0);
        for (int t = 0; t < TC; t += 2) {
            float y0, y1;
            SCAN_LD(X1, t + 1);
            SCAN_STEP(X0, y0);
            SCAN_LD(X0, t + 2);
            SCAN_STEP(X1, y1);
            if (kl == 0) { ys[t * 32 + row32] = y0; ys[(t + 1) * 32 + row32] = y1; }
        }
#undef SCAN_LD
#undef SCAN_STEP
        __syncthreads();
        {
            const int t = tid >> 4, r2 = (tid & 15) * 2;
            const f32x2 yv = *(const LAS f32x2*)(ys + t * 32 + r2);
            *(unsigned*)(Y + (tok0 + (size_t)chunk * TC + t) * D + h * 64 + 32 * half + r2) = cvtpk(yv[0], yv[1]);
        }
        if (chunk + 1 < NCH) SCAN_COMMIT(chunk + 1);
        __syncthreads();
    }
#undef SCAN_ISSUE
#undef SCAN_COMMIT
#undef ST8
}

constexpr int CH = 16, WINCH = 32, NWIN = (T / CH) / WINCH;
constexpr int CK_AT = 0, CK_RT = 2048, CK_KB = 4096, CK_VF = 8192, CK_G1 = 10240, CK_G2 = 10752, CK_G3 = 11264, CK_W = 12288, CK_BYTES = 12544;
constexpr int PREP_LDS = 14336;
struct PrepRaw { u32x4 q[2][9]; };
__device__ __forceinline__ void rwkv_prep_issue(PrepRaw& R, int hh, int c, const bf16_t* P, const unsigned short* WL, const bf16_t* AB, const bf16_t* KKb, int lane) {
    const int b = hh / 12, h = hh % 12; const size_t tok0 = (size_t)b * T + (size_t)c * CH; const int chn = h * 64 + (lane & 7) * 8;
#pragma unroll
    for (int i = 0; i < 2; ++i) { const int row = (lane >> 3) + 8 * i; const size_t tok = tok0 + row; const size_t tokp = (c == 0 && row == 0) ? tok : tok - 1;
        R.q[i][0] = *(const u32x4*)(P + tok * AIN + chn); R.q[i][1] = *(const u32x4*)(P + tokp * AIN + chn);
        R.q[i][2] = *(const u32x4*)(P + tok * AIN + RW + chn); R.q[i][3] = *(const u32x4*)(P + tokp * AIN + RW + chn);
        R.q[i][4] = *(const u32x4*)(P + tok * AIN + 1536 + chn); R.q[i][5] = *(const u32x4*)(P + tokp * AIN + 1536 + chn);
        R.q[i][6] = *(const u32x4*)(AB + tok * RW + chn); R.q[i][7] = *(const u32x4*)(KKb + tok * RW + chn); R.q[i][8] = *(const u32x4*)(WL + tok * RW + chn); }
}
__device__ __forceinline__ void rwkv_prep_compute(LAS unsigned char* L, int hh, int c, unsigned char* rec, PrepRaw& R, const bf16_t* P, const unsigned short* WL, const bf16_t* AB, const bf16_t* KKb,
                                                  const float* mu, const float* k_a, const float* r_k, float* RK, int lane, bool has_next, int hh_n, int c_n) {
    const int b = hh / 12, h = hh % 12; const size_t tok0 = (size_t)b * T + (size_t)c * CH;
    LAS float* Wf = (LAS float*)L;
    LAS bf16_t* tKK = (LAS bf16_t*)(L + 4096); LAS bf16_t* tR = (LAS bf16_t*)(L + 6144); LAS bf16_t* tKM = (LAS bf16_t*)(L + 8192); LAS bf16_t* tB = (LAS bf16_t*)(L + 10240); LAS bf16_t* tV = (LAS bf16_t*)(L + 12288);
    const int lr = lane & 15, Q = lane >> 4;
    {
        const int c8 = (lane & 7) * 8, chn = h * 64 + c8;
        float mr[8], mk[8], mv[8], ka8[8], rk8[8];
        *(f32x4*)mr = *(const f32x4*)(mu + chn); *(f32x4*)(mr + 4) = *(const f32x4*)(mu + chn + 4);
        *(f32x4*)mk = *(const f32x4*)(mu + RW + chn); *(f32x4*)(mk + 4) = *(const f32x4*)(mu + RW + chn + 4);
        *(f32x4*)mv = *(const f32x4*)(mu + 1536 + chn); *(f32x4*)(mv + 4) = *(const f32x4*)(mu + 1536 + chn + 4);
        *(f32x4*)ka8 = *(const f32x4*)(k_a + chn); *(f32x4*)(ka8 + 4) = *(const f32x4*)(k_a + chn + 4);
        *(f32x4*)rk8 = *(const f32x4*)(r_k + chn); *(f32x4*)(rk8 + 4) = *(const f32x4*)(r_k + chn + 4);
#pragma unroll
        for (int i = 0; i < 2; ++i) {
            const int row = (lane >> 3) + 8 * i; const size_t tok = tok0 + row; const bool z = (c == 0 && row == 0);
            const u32x4 qr = R.q[i][0], qrp = R.q[i][1], qk = R.q[i][2], qkp = R.q[i][3], qv = R.q[i][4], qvp = R.q[i][5], qa = R.q[i][6], qkk = R.q[i][7], qw = R.q[i][8];
            float pc[8], pp[8], rr[8], km[8], vv[8], av[8], kk[8], bb[8], ww[8];
            unpack8(qr, pc); unpack8(qrp, pp);
#pragma unroll
            for (int j = 0; j < 8; ++j) { const float pv = z ? 0.f : pp[j]; rr[j] = pc[j] + (pv - pc[j]) * mr[j]; }
            unpack8(qk, pc); unpack8(qkp, pp); unpack8(qa, av); unpack8(qkk, kk);
            float rks = 0.f;
#pragma unroll
            for (int j = 0; j < 8; ++j) { const float pv = z ? 0.f : pp[j]; const float kx = pc[j] + (pv - pc[j]) * mk[j]; km[j] = kx * (1.0f + (av[j] - 1.0f) * ka8[j]); bb[j] = kk[j] * av[j]; rks += rr[j] * km[j] * rk8[j]; }
            unpack8(qv, pc); unpack8(qvp, pp);
#pragma unroll
            for (int j = 0; j < 8; ++j) { const float pv = z ? 0.f : pp[j]; vv[j] = pc[j] + (pv - pc[j]) * mv[j]; }
            rks = red8(rks);
            if ((lane & 7) == 0) RK[tok * 12 + h] = rks;
            ww[0] = __expf(h2f((unsigned short)(qw.x & 0xffffu))); ww[1] = __expf(h2f((unsigned short)(qw.x >> 16))); ww[2] = __expf(h2f((unsigned short)(qw.y & 0xffffu))); ww[3] = __expf(h2f((unsigned short)(qw.y >> 16)));
            ww[4] = __expf(h2f((unsigned short)(qw.z & 0xffffu))); ww[5] = __expf(h2f((unsigned short)(qw.z >> 16))); ww[6] = __expf(h2f((unsigned short)(qw.w & 0xffffu))); ww[7] = __expf(h2f((unsigned short)(qw.w >> 16)));
            *(LAS f32x4*)(Wf + row * 64 + c8) = (f32x4){ww[0], ww[1], ww[2], ww[3]}; *(LAS f32x4*)(Wf + row * 64 + c8 + 4) = (f32x4){ww[4], ww[5], ww[6], ww[7]};
            *(LAS u32x4*)(tKK + row * 64 + c8) = pack8(kk); *(LAS u32x4*)(tR + row * 64 + c8) = pack8(rr); *(LAS u32x4*)(tKM + row * 64 + c8) = pack8(km);
            *(LAS u32x4*)(tB + row * 64 + c8) = pack8(bb); *(LAS u32x4*)(tV + row * 64 + c8) = pack8(vv);
        }
    }
    if (has_next) rwkv_prep_issue(R, hh_n, c_n, P, WL, AB, KKb, lane);
    asm volatile("s_waitcnt lgkmcnt(0)" ::: "memory");
    {
        const int cp = lane & 31, hf = lane >> 5;
        float wl0[8], wl1[8]; float a0 = 1.0f, a1 = 1.0f;
#pragma unroll
        for (int tt = 0; tt < 8; ++tt) { const f32x2 w2 = *(const LAS f32x2*)(Wf + (8 * hf + tt) * 64 + 2 * cp); a0 *= w2.x; a1 *= w2.y; wl0[tt] = a0; wl1[tt] = a1; }
        asm volatile("s_waitcnt lgkmcnt(0)" ::: "memory");
        if (hf == 0) *(LAS f32x2*)(Wf + 2 * cp) = (f32x2){a0, a1};
        asm volatile("s_waitcnt lgkmcnt(0)" ::: "memory");
        f32x2 bs = (f32x2){1.0f, 1.0f};
        if (hf == 1) bs = *(const LAS f32x2*)(Wf + 2 * cp);
        float kap0[8], kap1[8], bet0[8], bet1[8]; unsigned vraw[8];
#pragma unroll
        for (int tt = 0; tt < 8; ++tt) {
            const int t = 8 * hf + tt;
            const float W0 = bs.x * wl0[tt], W1 = bs.y * wl1[tt]; const float P0 = (tt == 0) ? bs.x : bs.x * wl0[tt > 0 ? tt - 1 : 0], P1 = (tt == 0) ? bs.y : bs.y * wl1[tt > 0 ? tt - 1 : 0];
            const float i0 = __builtin_amdgcn_rcpf(W0), i1 = __builtin_amdgcn_rcpf(W1);
            const unsigned qkk = *(const LAS unsigned*)(tKK + t * 64 + 2 * cp), qr = *(const LAS unsigned*)(tR + t * 64 + 2 * cp), qkm = *(const LAS unsigned*)(tKM + t * 64 + 2 * cp), qb = *(const LAS unsigned*)(tB + t * 64 + 2 * cp);
            vraw[tt] = *(const LAS unsigned*)(tV + t * 64 + 2 * cp);
            kap0[tt] = bflo(qkm) * i0; kap1[tt] = bfhi(qkm) * i1; bet0[tt] = bflo(qb) * i0; bet1[tt] = bfhi(qb) * i1;
            *(LAS unsigned*)(tKK + t * 64 + 2 * cp) = cvtpk(P0 * bflo(qkk), P1 * bfhi(qkk)); *(LAS unsigned*)(tR + t * 64 + 2 * cp) = cvtpk(W0 * bflo(qr), W1 * bfhi(qr));
            *(LAS unsigned*)(tKM + t * 64 + 2 * cp) = cvtpk(kap0[tt], kap1[tt]); *(LAS unsigned*)(tB + t * 64 + 2 * cp) = cvtpk(bet0[tt], bet1[tt]);
        }
        u32x4* kbp = (u32x4*)(rec + CK_KB); u32x2* vfp = (u32x2*)(rec + CK_VF);
        const int k0 = 2 * cp, kt0 = k0 >> 4, r0 = k0 & 15;
#pragma unroll
        for (int q = 0; q < 2; ++q) { const int Qp = 2 * hf + q;
            u32x4 wa; wa.x = cvtpk(kap0[4 * q], kap0[4 * q + 1]); wa.y = cvtpk(kap0[4 * q + 2], kap0[4 * q + 3]); wa.z = cvtpk(-bet0[4 * q], -bet0[4 * q + 1]); wa.w = cvtpk(-bet0[4 * q + 2], -bet0[4 * q + 3]);
            u32x4 wb; wb.x = cvtpk(kap1[4 * q], kap1[4 * q + 1]); wb.y = cvtpk(kap1[4 * q + 2], kap1[4 * q + 3]); wb.z = cvtpk(-bet1[4 * q], -bet1[4 * q + 1]); wb.w = cvtpk(-bet1[4 * q + 2], -bet1[4 * q + 3]);
            kbp[(kt0 * 4 + Qp) * 16 + r0] = wa; kbp[(kt0 * 4 + Qp) * 16 + r0 + 1] = wb;
            u32x2 va; va.x = (vraw[4 * q] & 0xffffu) | (vraw[4 * q + 1] << 16); va.y = (vraw[4 * q + 2] & 0xffffu) | (vraw[4 * q + 3] << 16);
            u32x2 vb; vb.x = (vraw[4 * q] >> 16) | (vraw[4 * q + 1] & 0xffff0000u); vb.y = (vraw[4 * q + 2] >> 16) | (vraw[4 * q + 3] & 0xffff0000u);
            vfp[(kt0 * 4 + Qp) * 16 + r0] = va; vfp[(kt0 * 4 + Qp) * 16 + r0 + 1] = vb; }
        if (hf == 1) *(f32x2*)((float*)(rec + CK_W) + 2 * cp) = (f32x2){bs.x * wl0[7], bs.y * wl1[7]};
    }
    asm volatile("s_waitcnt lgkmcnt(0)" ::: "memory");
    {
        bf16x8 aB[2], aK[2], bA[2], bR[2];
#pragma unroll
        for (int p = 0; p < 2; ++p) { const int o = lr * 64 + 32 * p + 8 * Q;
            aB[p] = *(const LAS bf16x8*)(tB + o); aK[p] = *(const LAS bf16x8*)(tKM + o); bA[p] = *(const LAS bf16x8*)(tKK + o); bR[p] = *(const LAS bf16x8*)(tR + o); }
        const f32x4 z4 = (f32x4){0.f, 0.f, 0.f, 0.f};
        f32x4 Nb = __builtin_amdgcn_mfma_f32_16x16x32_bf16(aB[0], bA[0], z4, 0, 0, 0); Nb = __builtin_amdgcn_mfma_f32_16x16x32_bf16(aB[1], bA[1], Nb, 0, 0, 0);
        f32x4 Nk = __builtin_amdgcn_mfma_f32_16x16x32_bf16(aK[0], bA[0], z4, 0, 0, 0); Nk = __builtin_amdgcn_mfma_f32_16x16x32_bf16(aK[1], bA[1], Nk, 0, 0, 0);
        f32x4 Mk = __builtin_amdgcn_mfma_f32_16x16x32_bf16(aK[0], bR[0], z4, 0, 0, 0); Mk = __builtin_amdgcn_mfma_f32_16x16x32_bf16(aK[1], bR[1], Mk, 0, 0, 0);
        f32x4 Mb = __builtin_amdgcn_mfma_f32_16x16x32_bf16(aB[0], bR[0], z4, 0, 0, 0); Mb = __builtin_amdgcn_mfma_f32_16x16x32_bf16(aB[1], bR[1], Mb, 0, 0, 0);
#pragma unroll
        for (int r = 0; r < 4; ++r) { const int j = 4 * Q + r; if (!(j < lr)) { Nb[r] = 0.f; Nk[r] = 0.f; } if (!(j <= lr)) { Mk[r] = 0.f; Mb[r] = 0.f; } }
        u32x2 g1; g1.x = cvtpk(Nk[0], Nk[1]); g1.y = cvtpk(Nk[2], Nk[3]); ((u32x2*)(rec + CK_G1))[lane] = g1;
        u32x4 g3; g3.x = cvtpk(Mk[0], Mk[1]); g3.y = cvtpk(Mk[2], Mk[3]); g3.z = cvtpk(-Mb[0], -Mb[1]); g3.w = cvtpk(-Mb[2], -Mb[3]); ((u32x4*)(rec + CK_G3))[lane] = g3;
        *(LAS f32x4*)(Wf + lr * 16 + 4 * Q) = Nb;
    }
    asm volatile("s_waitcnt lgkmcnt(0)" ::: "memory");
    {
        float Tr[16];
#pragma unroll
        for (int t = 0; t < 16; ++t) {
            const f32x4 zz = (f32x4){0.f, 0.f, 0.f, 0.f};
            const f32x4 n0 = (t > 0) ? *(const LAS f32x4*)(Wf + t * 16) : zz, n1 = (t > 4) ? *(const LAS f32x4*)(Wf + t * 16 + 4) : zz, n2 = (t > 8) ? *(const LAS f32x4*)(Wf + t * 16 + 8) : zz, n3 = (t > 12) ? *(const LAS f32x4*)(Wf + t * 16 + 12) : zz;
            const float nt[16] = {n0[0], n0[1], n0[2], n0[3], n1[0], n1[1], n1[2], n1[3], n2[0], n2[1], n2[2], n2[3], n3[0], n3[1], n3[2], n3[3]};
            float sacc = (t == lr) ? 1.0f : 0.0f;
#pragma unroll
            for (int m = 0; m < t; ++m) sacc -= Tr[m] * nt[m];
            Tr[t] = sacc;
        }
        if (Q == 0) {
#pragma unroll
            for (int q = 0; q < 4; ++q) *(LAS f32x4*)(Wf + 256 + lr * 16 + 4 * q) = (f32x4){Tr[4 * q], Tr[4 * q + 1], Tr[4 * q + 2], Tr[4 * q + 3]}; }
    }
    asm volatile("s_waitcnt lgkmcnt(0)" ::: "memory");
    {
        u32x2 g2; g2.x = cvtpk(Wf[256 + (4 * Q) * 16 + lr], Wf[256 + (4 * Q + 1) * 16 + lr]); g2.y = cvtpk(Wf[256 + (4 * Q + 2) * 16 + lr], Wf[256 + (4 * Q + 3) * 16 + lr]);
        ((u32x2*)(rec + CK_G2))[lane] = g2;
#pragma unroll
        for (int p = 0; p < 2; ++p) { const int o = lr * 64 + 32 * p + 4 * Q;
            const u32x2 alo = *(const LAS u32x2*)(tKK + o), ahi = *(const LAS u32x2*)(tKK + o + 16), rlo = *(const LAS u32x2*)(tR + o), rhi = *(const LAS u32x2*)(tR + o + 16);
            ((u32x4*)(rec + CK_AT))[p * 64 + lane] = (u32x4){alo.x, alo.y, ahi.x, ahi.y}; ((u32x4*)(rec + CK_RT))[p * 64 + lane] = (u32x4){rlo.x, rlo.y, rhi.x, rhi.y}; }
    }
    asm volatile("s_waitcnt lgkmcnt(0)" ::: "memory");
}
__device__ __forceinline__ void rwkv_prep_chunk(LAS unsigned char* L, int hh, int c, unsigned char* rec, const bf16_t* P, const unsigned short* WL, const bf16_t* AB, const bf16_t* KKb,
                                                const float* mu, const float* k_a, const float* r_k, float* RK, int lane) {
    PrepRaw R; rwkv_prep_issue(R, hh, c, P, WL, AB, KKb, lane);
    rwkv_prep_compute(L, hh, c, rec, R, P, WL, AB, KKb, mu, k_a, r_k, RK, lane, false, 0, 0);
}
template <int CTRL> __device__ __forceinline__ float dpp_keep(float old, float x) { return __int_as_float(__builtin_amdgcn_update_dpp(__float_as_int(old), __float_as_int(x), CTRL, 0xf, 0xf, false)); }
__device__ __forceinline__ void rwkv_prep2(LAS unsigned char* L, int hh, int c, unsigned char* rec, const bf16_t* P, const unsigned short* WL, const bf16_t* AB, const float* k_k,
                                           const float* mu, const float* k_a, const float* r_k, float* RK, int lane_) {
    int lane = lane_; asm volatile("" : "+v"(lane));
    const int b = hh / 12, h = hh % 12; const size_t tok0 = (size_t)b * T + (size_t)c * CH;
    LAS float* Wf = (LAS float*)L;
    const int t = lane & 15, cg = lane >> 4, lr = t, Q = cg;
    const int chn = h * 64 + 16 * cg; const size_t tok = tok0 + t;
    bf16x8 bA[2], bR[2], aK[2], aB[2], aV[2];
    float rks = 0.f;
    const bool first = (c == 0);
    float kxs[16]; float knorm;
    { float ss = 0.f;
#pragma unroll
      for (int hf = 0; hf < 2; ++hf) { const int ch = chn + 8 * hf; const unsigned po_ = (unsigned)tok * (unsigned)AIN + (unsigned)ch;
          const u32x4 qk = *(const u32x4*)(P + (po_ + RW)); u32x4 pk_ = (u32x4){0u, 0u, 0u, 0u}; if (t == 0 && !first) pk_ = *(const u32x4*)(P + (po_ - AIN + RW));
          float pc[8], po[8], m8[8], q8[8]; unpack8(qk, pc); unpack8(pk_, po);
          *(f32x4*)m8 = *(const f32x4*)(mu + RW + ch); *(f32x4*)(m8 + 4) = *(const f32x4*)(mu + RW + ch + 4); *(f32x4*)q8 = *(const f32x4*)(k_k + ch); *(f32x4*)(q8 + 4) = *(const f32x4*)(k_k + ch + 4);
#pragma unroll
          for (int j = 0; j < 8; ++j) { const float pv = dpp_keep<0x111>(po[j], pc[j]); const float kx = pc[j] + (pv - pc[j]) * m8[j]; kxs[8 * hf + j] = kx; const float kq = kx * q8[j]; ss += kq * kq; } }
      ss += __shfl_xor(ss, 16); ss += __shfl_xor(ss, 32);
      knorm = 1.0f / fmaxf(sqrtf(ss), 1e-12f); }
#pragma unroll
    for (int hf = 0; hf < 2; ++hf) {
        const int ch = chn + 8 * hf;
        const unsigned po_ = (unsigned)tok * (unsigned)AIN + (unsigned)ch, so_ = (unsigned)tok * (unsigned)RW + (unsigned)ch;
        const u32x4 qr = *(const u32x4*)(P + po_), qv = *(const u32x4*)(P + (po_ + 1536));
        const u32x4 qa = *(const u32x4*)(AB + so_), qw = *(const u32x4*)(WL + so_);
        u32x4 pr_ = (u32x4){0u, 0u, 0u, 0u}, pv_ = pr_;
        if (t == 0 && !first) { pr_ = *(const u32x4*)(P + (po_ - AIN)); pv_ = *(const u32x4*)(P + (po_ - AIN + 1536)); }
        float pc[8], po[8], av[8], rr[8], km[8], bb[8], kk[8], W[8], m8[8], g8[8];
        unpack8(qr, pc); unpack8(pr_, po); *(f32x4*)m8 = *(const f32x4*)(mu + ch); *(f32x4*)(m8 + 4) = *(const f32x4*)(mu + ch + 4);
#pragma unroll
        for (int j = 0; j < 8; ++j) { const float pv = dpp_keep<0x111>(po[j], pc[j]); rr[j] = pc[j] + (pv - pc[j]) * m8[j]; }
        unpack8(qa, av);
        *(f32x4*)m8 = *(const f32x4*)(k_k + ch); *(f32x4*)(m8 + 4) = *(const f32x4*)(k_k + ch + 4); *(f32x4*)g8 = *(const f32x4*)(k_a + ch); *(f32x4*)(g8 + 4) = *(const f32x4*)(k_a + ch + 4);
#pragma unroll
        for (int j = 0; j < 8; ++j) { const float kx = kxs[8 * hf + j]; kk[j] = kx * m8[j] * knorm;
            km[j] = kx * (1.0f + (av[j] - 1.0f) * g8[j]); bb[j] = kk[j] * av[j]; }
        *(f32x4*)g8 = *(const f32x4*)(r_k + ch); *(f32x4*)(g8 + 4) = *(const f32x4*)(r_k + ch + 4);
#pragma unroll
        for (int j = 0; j < 8; ++j) rks += rr[j] * km[j] * g8[j];
        unpack8(qv, pc); unpack8(pv_, po); *(f32x4*)m8 = *(const f32x4*)(mu + 1536 + ch); *(f32x4*)(m8 + 4) = *(const f32x4*)(mu + 1536 + ch + 4);
#pragma unroll
        for (int j = 0; j < 8; ++j) { const float pv = dpp_keep<0x111>(po[j], pc[j]); po[j] = pc[j] + (pv - pc[j]) * m8[j]; }
        aV[hf] = __builtin_bit_cast(bf16x8, pack8(po));
        W[0] = __expf(h2f((unsigned short)(qw.x & 0xffffu))); W[1] = __expf(h2f((unsigned short)(qw.x >> 16))); W[2] = __expf(h2f((unsigned short)(qw.y & 0xffffu))); W[3] = __expf(h2f((unsigned short)(qw.y >> 16)));
        W[4] = __expf(h2f((unsigned short)(qw.z & 0xffffu))); W[5] = __expf(h2f((unsigned short)(qw.z >> 16))); W[6] = __expf(h2f((unsigned short)(qw.w & 0xffffu))); W[7] = __expf(h2f((unsigned short)(qw.w >> 16)));
#pragma unroll
        for (int i = 0; i < 8; ++i) { float w = W[i];
            w *= dpp_keep<0x111>(1.0f, w); w *= dpp_keep<0x112>(1.0f, w); w *= dpp_keep<0x114>(1.0f, w); w *= dpp_keep<0x118>(1.0f, w);
            const float wp = dpp_keep<0x111>(1.0f, w); const float iw = __builtin_amdgcn_rcpf(w);
            W[i] = w; kk[i] *= wp; rr[i] *= w; km[i] *= iw; bb[i] *= iw; }
        bA[hf] = __builtin_bit_cast(bf16x8, pack8(kk)); bR[hf] = __builtin_bit_cast(bf16x8, pack8(rr)); aK[hf] = __builtin_bit_cast(bf16x8, pack8(km)); aB[hf] = __builtin_bit_cast(bf16x8, pack8(bb));
        if (t == 15) { *(f32x4*)((float*)(rec + CK_W) + 16 * (2 * hf) + 4 * cg) = (f32x4){W[0], W[1], W[2], W[3]}; *(f32x4*)((float*)(rec + CK_W) + 16 * (2 * hf + 1) + 4 * cg) = (f32x4){W[4], W[5], W[6], W[7]}; }
        asm volatile("" : "+v"(bA[hf]), "+v"(bR[hf]), "+v"(aK[hf]), "+v"(aB[hf]), "+v"(aV[hf]) : : "memory");
    }
    rks += __shfl_xor(rks, 16); rks += __shfl_xor(rks, 32);
    if (cg == 0) RK[tok * 12 + h] = rks;
    const f32x4 z4 = (f32x4){0.f, 0.f, 0.f, 0.f};
#pragma unroll
    for (int p = 0; p < 2; ++p) { ((u32x4*)(rec + CK_AT))[p * 64 + lane] = __builtin_bit_cast(u32x4, bA[p]); ((u32x4*)(rec + CK_RT))[p * 64 + lane] = __builtin_bit_cast(u32x4, bR[p]); }
    {
        const unsigned one = 0x3F80u; const bool on = (Q == (lr >> 2));
#pragma unroll
        for (int e = 0; e < 2; ++e) { const int slot = 4 * e + (lr & 3); const unsigned val = on ? (one << (16 * (slot & 1))) : 0u; const int wd = slot >> 1;
            const u32x4 selw = (u32x4){wd == 0 ? val : 0u, wd == 1 ? val : 0u, wd == 2 ? val : 0u, wd == 3 ? val : 0u}; const bf16x8 sel = __builtin_bit_cast(bf16x8, selw);
#pragma unroll
            for (int p = 0; p < 2; ++p) { const f32x4 Dk = __builtin_amdgcn_mfma_f32_16x16x32_bf16(aK[p], sel, z4, 0, 0, 0), Db = __builtin_amdgcn_mfma_f32_16x16x32_bf16(aB[p], sel, z4, 0, 0, 0);
                u32x4 w; w.x = cvtpk(Dk[0], Dk[1]); w.y = cvtpk(Dk[2], Dk[3]); w.z = cvtpk(-Db[0], -Db[1]); w.w = cvtpk(-Db[2], -Db[3]);
                ((u32x4*)(rec + CK_KB))[(2 * p + e) * 64 + lane] = w; } }
#pragma unroll
        for (int vt = 0; vt < 4; ++vt) { f32x4 Dv = z4;
#pragma unroll
            for (int p = 0; p < 2; ++p) { const bool onv = (Q == vt) && ((lr >> 3) == p); const int slot = lr & 7; const unsigned val = onv ? (one << (16 * (slot & 1))) : 0u; const int wd = slot >> 1;
                const u32x4 selw = (u32x4){wd == 0 ? val : 0u, wd == 1 ? val : 0u, wd == 2 ? val : 0u, wd == 3 ? val : 0u};
                Dv = __builtin_amdgcn_mfma_f32_16x16x32_bf16(aV[p], __builtin_bit_cast(bf16x8, selw), Dv, 0, 0, 0); }
            u32x2 w; w.x = cvtpk(Dv[0], Dv[1]); w.y = cvtpk(Dv[2], Dv[3]); ((u32x2*)(rec + CK_VF))[vt * 64 + lane] = w; }
    }
    {
        f32x4 Nb = __builtin_amdgcn_mfma_f32_16x16x32_bf16(aB[0], bA[0], z4, 0, 0, 0); Nb = __builtin_amdgcn_mfma_f32_16x16x32_bf16(aB[1], bA[1], Nb, 0, 0, 0);
        f32x4 Nk = __builtin_amdgcn_mfma_f32_16x16x32_bf16(aK[0], bA[0], z4, 0, 0, 0); Nk = __builtin_amdgcn_mfma_f32_16x16x32_bf16(aK[1], bA[1], Nk, 0, 0, 0);
        f32x4 Mk = __builtin_amdgcn_mfma_f32_16x16x32_bf16(aK[0], bR[0], z4, 0, 0, 0); Mk = __builtin_amdgcn_mfma_f32_16x16x32_bf16(aK[1], bR[1], Mk, 0, 0, 0);
        f32x4 Mb = __builtin_amdgcn_mfma_f32_16x16x32_bf16(aB[0], bR[0], z4, 0, 0, 0); Mb = __builtin_amdgcn_mfma_f32_16x16x32_bf16(aB[1], bR[1], Mb, 0, 0, 0);
#pragma unroll
        for (int r = 0; r < 4; ++r) { const int j = 4 * Q + r; if (!(j < lr)) { Nb[r] = 0.f; Nk[r] = 0.f; } if (!(j <= lr)) { Mk[r] = 0.f; Mb[r] = 0.f; } }
        u32x2 g1; g1.x = cvtpk(Nk[0], Nk[1]); g1.y = cvtpk(Nk[2], Nk[3]); ((u32x2*)(rec + CK_G1))[lane] = g1;
        u32x4 g3; g3.x = cvtpk(Mk[0], Mk[1]); g3.y = cvtpk(Mk[2], Mk[3]); g3.z = cvtpk(-Mb[0], -Mb[1]); g3.w = cvtpk(-Mb[2], -Mb[3]); ((u32x4*)(rec + CK_G3))[lane] = g3;
        *(LAS f32x4*)(Wf + lr * 16 + 4 * Q) = Nb;
    }
    asm volatile("s_waitcnt lgkmcnt(0)" ::: "memory");
    {
        float Tr[16];
#pragma unroll
        for (int tt = 0; tt < 16; ++tt) {
            const f32x4 zz = (f32x4){0.f, 0.f, 0.f, 0.f};
            const f32x4 n0 = (tt > 0) ? *(const LAS f32x4*)(Wf + tt * 16) : zz, n1 = (tt > 4) ? *(const LAS f32x4*)(Wf + tt * 16 + 4) : zz, n2 = (tt > 8) ? *(const LAS f32x4*)(Wf + tt * 16 + 8) : zz, n3 = (tt > 12) ? *(const LAS f32x4*)(Wf + tt * 16 + 12) : zz;
            const float nt[16] = {n0[0], n0[1], n0[2], n0[3], n1[0], n1[1], n1[2], n1[3], n2[0], n2[1], n2[2], n2[3], n3[0], n3[1], n3[2], n3[3]};
            float sacc = (tt == lr) ? 1.0f : 0.0f;
#pragma unroll
            for (int m = 0; m < tt; ++m) sacc -= Tr[m] * nt[m];
            Tr[tt] = sacc;
        }
        if (Q == 0) {
#pragma unroll
            for (int q = 0; q < 4; ++q) *(LAS f32x4*)(Wf + 256 + lr * 16 + 4 * q) = (f32x4){Tr[4 * q], Tr[4 * q + 1], Tr[4 * q + 2], Tr[4 * q + 3]}; }
    }
    asm volatile("s_waitcnt lgkmcnt(0)" ::: "memory");
    { u32x2 g2; g2.x = cvtpk(Wf[256 + (4 * Q) * 16 + lr], Wf[256 + (4 * Q + 1) * 16 + lr]); g2.y = cvtpk(Wf[256 + (4 * Q + 2) * 16 + lr], Wf[256 + (4 * Q + 3) * 16 + lr]);
      ((u32x2*)(rec + CK_G2))[lane] = g2; }
    asm volatile("s_waitcnt lgkmcnt(0)" ::: "memory");
}
struct ChunkRec { u32x4 at0, at1, rt0, rt1, kb0, kb1, kb2, kb3, g3; u32x2 vf, g1, g2; f32x4 w0, w1, w2, w3; };
constexpr int RING_SLOTS = 8, RING_DIST = 6;
__device__ __forceinline__ void rwkv_seq_window(LAS unsigned char* lds, int hh, int win, const unsigned char* CKBw, float* SBUF, bf16_t* Y, int tid) {
    const int wave = __builtin_amdgcn_readfirstlane(tid >> 6), lane = tid & 63;
    const unsigned char* rec0 = CKBw + (size_t)hh * WINCH * CK_BYTES;
    if (wave >= 4) {
        const int lw = wave - 4;
#define RING_ISSUE(chunk_) do { const unsigned char* g_ = rec0 + (size_t)(chunk_) * CK_BYTES + lane * 16; LAS unsigned char* d_ = lds + ((chunk_) & (RING_SLOTS - 1)) * CK_BYTES; \
            __builtin_amdgcn_global_load_lds((const unsigned*)(g_ + lw * 1024), (LAS unsigned*)(d_ + lw * 1024), 16, 0, 0); \
            __builtin_amdgcn_global_load_lds((const unsigned*)(g_ + (lw + 4) * 1024), (LAS unsigned*)(d_ + (lw + 4) * 1024), 16, 0, 0); \
            __builtin_amdgcn_global_load_lds((const unsigned*)(g_ + (lw + 8) * 1024), (LAS unsigned*)(d_ + (lw + 8) * 1024), 16, 0, 0); \
            if (lw == 0 && lane < 16) __builtin_amdgcn_global_load_lds((const unsigned*)(g_ + 12288), (LAS unsigned*)(d_ + 12288), 16, 0, 0); } while (0)
#pragma unroll
        for (int c = 0; c < RING_DIST; ++c) RING_ISSUE(c);
        asm volatile("s_waitcnt vmcnt(12)" ::: "memory");
        __builtin_amdgcn_s_barrier();
        for (int c = 0; c < WINCH; ++c) {
            if (c + RING_DIST < WINCH) { RING_ISSUE(c + RING_DIST); asm volatile("s_waitcnt vmcnt(12)" ::: "memory"); }
            else asm volatile("s_waitcnt vmcnt(0)" ::: "memory");
            __builtin_amdgcn_s_barrier();
        }
#undef RING_ISSUE
        return;
    }
    const int vt = wave, lr = lane & 15, Q = lane >> 4, b = hh / 12, h = hh % 12;
    f32x4 S0, S1, S2, S3;
    f32x4* sb = (f32x4*)SBUF + ((size_t)(hh * 4 + vt) * 4) * 64 + lane;
    if (win == 0) { S0 = S1 = S2 = S3 = (f32x4){0.f, 0.f, 0.f, 0.f}; } else { S0 = sb[0]; S1 = sb[64]; S2 = sb[128]; S3 = sb[192]; }
#define CK_LOAD(R, chunk_) do { const LAS unsigned char* q_ = lds + ((chunk_) & (RING_SLOTS - 1)) * CK_BYTES; R.at0 = ((const LAS u32x4*)(q_ + CK_AT))[lane]; R.at1 = ((const LAS u32x4*)(q_ + CK_AT))[64 + lane]; R.rt0 = ((const LAS u32x4*)(q_ + CK_RT))[lane]; R.rt1 = ((const LAS u32x4*)(q_ + CK_RT))[64 + lane]; \
        R.kb0 = ((const LAS u32x4*)(q_ + CK_KB))[lane]; R.kb1 = ((const LAS u32x4*)(q_ + CK_KB))[64 + lane]; R.kb2 = ((const LAS u32x4*)(q_ + CK_KB))[128 + lane]; R.kb3 = ((const LAS u32x4*)(q_ + CK_KB))[192 + lane]; \
        R.g3 = ((const LAS u32x4*)(q_ + CK_G3))[lane]; R.vf = ((const LAS u32x2*)(q_ + CK_VF))[vt * 64 + lane]; R.g1 = ((const LAS u32x2*)(q_ + CK_G1))[lane]; R.g2 = ((const LAS u32x2*)(q_ + CK_G2))[lane]; \
        const LAS float* w_ = (const LAS float*)(q_ + CK_W) + 4 * Q; R.w0 = *(const LAS f32x4*)(w_); R.w1 = *(const LAS f32x4*)(w_ + 16); R.w2 = *(const LAS f32x4*)(w_ + 32); R.w3 = *(const LAS f32x4*)(w_ + 48); } while (0)
#define BF8(x) __builtin_bit_cast(bf16x8, (x))
#define CK_STEP(R, cw_) do { const f32x4 z4 = (f32x4){0.f, 0.f, 0.f, 0.f}; \
        const u32x4 bS0 = (u32x4){cvtpk(S0[0], S0[1]), cvtpk(S0[2], S0[3]), cvtpk(S1[0], S1[1]), cvtpk(S1[2], S1[3])}, bS1 = (u32x4){cvtpk(S2[0], S2[1]), cvtpk(S2[2], S2[3]), cvtpk(S3[0], S3[1]), cvtpk(S3[2], S3[3])}; \
        f32x4 Z = __builtin_amdgcn_mfma_f32_16x16x32_bf16(BF8(((u32x4){R.g1.x, R.g1.y, 0u, 0u})), BF8(((u32x4){R.vf.x, R.vf.y, 0u, 0u})), z4, 0, 0, 0); \
        Z = __builtin_amdgcn_mfma_f32_16x16x32_bf16(BF8(R.at0), BF8(bS0), Z, 0, 0, 0); Z = __builtin_amdgcn_mfma_f32_16x16x32_bf16(BF8(R.at1), BF8(bS1), Z, 0, 0, 0); \
        f32x4 Yt = __builtin_amdgcn_mfma_f32_16x16x32_bf16(BF8(R.rt0), BF8(bS0), z4, 0, 0, 0); Yt = __builtin_amdgcn_mfma_f32_16x16x32_bf16(BF8(R.rt1), BF8(bS1), Yt, 0, 0, 0); \
        const f32x4 Dm = __builtin_amdgcn_mfma_f32_16x16x32_bf16(BF8(((u32x4){R.g2.x, R.g2.y, 0u, 0u})), BF8(((u32x4){cvtpk(Z[0], Z[1]), cvtpk(Z[2], Z[3]), 0u, 0u})), z4, 0, 0, 0); \
        const u32x4 bVD = (u32x4){R.vf.x, R.vf.y, cvtpk(Dm[0], Dm[1]), cvtpk(Dm[2], Dm[3])}; \
        Yt = __builtin_amdgcn_mfma_f32_16x16x32_bf16(BF8(R.g3), BF8(bVD), Yt, 0, 0, 0); \
        S0 = __builtin_amdgcn_mfma_f32_16x16x32_bf16(BF8(R.kb0), BF8(bVD), S0, 0, 0, 0) * R.w0; S1 = __builtin_amdgcn_mfma_f32_16x16x32_bf16(BF8(R.kb1), BF8(bVD), S1, 0, 0, 0) * R.w1; \
        S2 = __builtin_amdgcn_mfma_f32_16x16x32_bf16(BF8(R.kb2), BF8(bVD), S2, 0, 0, 0) * R.w2; S3 = __builtin_amdgcn_mfma_f32_16x16x32_bf16(BF8(R.kb3), BF8(bVD), S3, 0, 0, 0) * R.w3; \
        bf16_t* yp_ = Y + ((size_t)b * T + (size_t)(win * WINCH + (cw_)) * CH + 4 * Q) * D + h * 64 + 16 * vt + lr; \
        yp_[0] = f2bf(Yt[0]); yp_[D] = f2bf(Yt[1]); yp_[2 * D] = f2bf(Yt[2]); yp_[3 * D] = f2bf(Yt[3]); } while (0)
    ChunkRec RA, RB;
    __builtin_amdgcn_s_barrier();
    CK_LOAD(RA, 0);
    for (int cw = 0; cw < WINCH; cw += 2) {
        CK_LOAD(RB, cw + 1);
        CK_STEP(RA, cw);
        asm volatile("s_waitcnt lgkmcnt(0)" ::: "memory");
        __builtin_amdgcn_s_barrier();
        if (cw + 2 < WINCH) CK_LOAD(RA, cw + 2);
        CK_STEP(RB, cw + 1);
        asm volatile("s_waitcnt lgkmcnt(0)" ::: "memory");
        __builtin_amdgcn_s_barrier();
    }
#undef CK_LOAD
#undef CK_STEP
#undef BF8
    sb[0] = S0; sb[64] = S1; sb[128] = S2; sb[192] = S3;
}

#define XB_TMO      128
#define XB_XCNT(j)  (256  + 64 * (j))
#define XB_XSUB(j)  (1280 + 64 * (j))
#define XB_XGEN(j)  (2304 + 64 * (j))
#define XB_TOP      3328
#define XB_TOPGEN   3392
#define XCD_BAR_WORDS 3456
#define XB_SPIN_CAP (1u << 22)
__device__ __forceinline__ unsigned xb_ld(unsigned* p)              { return __hip_atomic_load(p, __ATOMIC_RELAXED, __HIP_MEMORY_SCOPE_AGENT); }
__device__ __forceinline__ unsigned xb_add(unsigned* p, unsigned v) { return __hip_atomic_fetch_add(p, v, __ATOMIC_RELAXED, __HIP_MEMORY_SCOPE_AGENT); }
__device__ __forceinline__ unsigned xb_xcc_id() { return (unsigned)__builtin_amdgcn_s_getreg((3 << 11) | 20) & 0xFu; }
#define XB_SPIN(cond, bar) do { unsigned _sp = 0; while (cond) { __builtin_amdgcn_s_sleep(1); \
    if ((++_sp & 255u) == 0u) { if (xb_ld(&(bar)[XB_TMO])) break; if (_sp > XB_SPIN_CAP) { atomicAdd(&(bar)[XB_TMO], 1u); break; } } } } while (0)
struct XcdBarrier { unsigned* bar; unsigned x; volatile LAS unsigned* st; };
__device__ __forceinline__ XcdBarrier xcd_barrier_post(unsigned* bar, volatile LAS unsigned* st) {
    XcdBarrier b; b.bar = bar; b.x = xb_xcc_id(); b.st = st;
    if (threadIdx.x == 0) (void)xb_add(&bar[XB_XCNT(b.x)], 1u);
    return b;
}
__device__ __forceinline__ void xcd_barrier_complete(unsigned* bar, unsigned x, unsigned& nloc, unsigned& nx) {
    const unsigned G = gridDim.x * gridDim.y * gridDim.z;
    unsigned sum, cnt, mine, sp = 0u;
    for (;;) {
        sum = 0u; cnt = 0u; mine = 0u;
#pragma unroll
        for (unsigned j = 0; j < 16; ++j) { const unsigned c = xb_ld(&bar[XB_XCNT(j)]); sum += c; cnt += (c > 0u) ? 1u : 0u; mine = (j == x) ? c : mine; }
        if (sum == G) break;
        __builtin_amdgcn_s_sleep(1);
        if ((++sp & 255u) == 0u) { if (xb_ld(&bar[XB_TMO])) break; if (sp > XB_SPIN_CAP) { atomicAdd(&bar[XB_TMO], 1u); break; } }
    }
    nloc = mine > 0u ? mine : 1u; nx = cnt > 0u ? cnt : 1u;
}
__device__ __forceinline__ void xcd_barrier(const XcdBarrier& b) {
    asm volatile("s_waitcnt vmcnt(0)" ::: "memory");
    __syncthreads();
    if (threadIdx.x == 0) {
        unsigned* bar = b.bar;
        __builtin_amdgcn_s_waitcnt(0);
        unsigned nloc = b.st[0], nx = b.st[1];
        if (nloc == 0u) { xcd_barrier_complete(bar, b.x, nloc, nx); b.st[0] = nloc; b.st[1] = nx; }
        const unsigned old = xb_add(&bar[XB_XSUB(b.x)], 1u);
        const unsigned gen = old / nloc;
        if (old + 1u == (gen + 1u) * nloc) {
            __builtin_amdgcn_fence(__ATOMIC_RELEASE, "agent");
            asm volatile("s_waitcnt vmcnt(0)" ::: "memory");
            const unsigned og = xb_add(&bar[XB_TOP], 1u);
            const unsigned tg = og / nx;
            if (og + 1u == (tg + 1u) * nx) xb_add(&bar[XB_TOPGEN], 1u);
            else XB_SPIN(xb_ld(&bar[XB_TOPGEN]) == tg, bar);
            __builtin_amdgcn_fence(__ATOMIC_ACQUIRE, "agent");
            xb_add(&bar[XB_XGEN(b.x)], 1u);
            asm volatile("s_waitcnt vmcnt(0)" ::: "memory");
        } else {
            XB_SPIN(xb_ld(&bar[XB_XGEN(b.x)]) == gen, bar);
            __builtin_amdgcn_fence(__ATOMIC_ACQUIRE, "agent");
            asm volatile("s_waitcnt vmcnt(0)" ::: "memory");
        }
    }
    __syncthreads();
}

__device__ __forceinline__ void fixup_panel(int tid, int pm, const float* cw, const float* cb, const float* HU, bf16_t* Z) {
    for (int i = tid; i < 4 * (FF / 4); i += 512) {
        const int c = (i % (FF / 4)) * 4, gs = 4 * pm + i / (FF / 4), s = gs & 1, grp = gs >> 1; const bool first = (grp & 31) == 0;
        const float* h0 = HU + (size_t)grp * 4 * FF2; const float* hp = HU + (size_t)(grp - 1) * 4 * FF2;
        const f32x4 z4 = (f32x4){0.f, 0.f, 0.f, 0.f};
        float zz[4];
#pragma unroll
        for (int half = 0; half < 2; ++half) {
            const int cc = half * FF + c;
            const f32x4 ut = *(const f32x4*)(h0 + (size_t)s * FF2 + cc);
            const f32x4 u1 = s ? *(const f32x4*)(h0 + cc) : (first ? z4 : *(const f32x4*)(hp + 3 * (size_t)FF2 + cc));
            const f32x4 u2 = s ? (first ? z4 : *(const f32x4*)(hp + 3 * (size_t)FF2 + cc)) : (first ? z4 : *(const f32x4*)(hp + 2 * (size_t)FF2 + cc));
            const f32x4 cv = *(const f32x4*)(cb + cc) + *(const f32x4*)(cw + cc) * u2 + *(const f32x4*)(cw + FF2 + cc) * u1 + *(const f32x4*)(cw + 2 * FF2 + cc) * ut;
#pragma unroll
            for (int j = 0; j < 4; ++j) zz[j] = half ? zz[j] * cv[j] : cv[j] * sigmoidf_(cv[j]);
        }
        u32x2 w; w.x = cvtpk(zz[0], zz[1]); w.y = cvtpk(zz[2], zz[3]);
        *(u32x2*)(Z + (size_t)(grp * 128 + s) * FF + c) = w;
    }
}

constexpr int NPH = 20;
constexpr int LDS_BYTES = 147456;
__global__ void __launch_bounds__(512, 2) mega(Params p) {
    extern __shared__ __attribute__((aligned(16))) unsigned char lds_raw[];
    LAS unsigned char* lds = (LAS unsigned char*)lds_raw;
    cg::grid_group grid = cg::this_grid();
    const int G = gridDim.x, bx = blockIdx.x;
    const int ngw = G * 8;
#define PH_BEGIN int tid = threadIdx.x; asm volatile("" : "+v"(tid)); const int lane = tid & 63, wave = __builtin_amdgcn_readfirstlane(tid >> 6), gw = bx * 8 + wave; (void)lane; (void)gw;
    unsigned char* ws = p.ws;
    unsigned* ctl = (unsigned*)(ws + WS_CTL);
    float* out = p.out;
    bf16_t* XN = (bf16_t*)(ws + WS_A); bf16_t* Y = (bf16_t*)(ws + WS_Y); bf16_t* P = (bf16_t*)(ws + WS_P); float* X2 = (float*)(ws + WS_X2);
    unsigned short* WL = (unsigned short*)(ws + WS_WL); bf16_t* AB = (bf16_t*)(ws + WS_KMOD); bf16_t* Gt = (bf16_t*)(ws + WS_G);
    bf16_t* KK = (bf16_t*)((unsigned char*)out + DO_KK); bf16_t* ACT = (bf16_t*)((unsigned char*)out + DO_ACT);
    float* ROPE = (float*)(ws + WS_ROPE); bf16_t* MEMN = (bf16_t*)(ws + WS_MEMN); bf16_t* MEMKV = (bf16_t*)(ws + WS_MEMKV); float* LSE = (float*)(ws + WS_LSE); float* SSQ = (float*)(ws + WS_SSQ); float* RS = (float*)(ws + WS_RS);
    bf16_t* XN1 = (bf16_t*)(ws + WS_XN1); bf16_t* Y1 = (bf16_t*)(ws + WS_Y1); bf16_t* OG = (bf16_t*)(ws + WS_OG);
#ifndef PHMASK
#define PHMASK 0xfffff
#endif
#define IN(k) ((((PHMASK) >> (k)) & 1) && p.ph_lo <= (k) && (k) < p.ph_hi)
#define SYNC(k) do { if (IN(k) && IN((k) + 1)) xcd_barrier(xbar); } while (0)
    if (p.ph_lo > 1000) grid.sync();
    { volatile LAS unsigned* st = (volatile LAS unsigned*)(lds + 140032); if (threadIdx.x == 0) { st[0] = 0u; st[1] = 0u; } __syncthreads(); }
    const XcdBarrier xbar = xcd_barrier_post(ctl + 4096, (volatile LAS unsigned*)(lds + 140032));

    if (IN(0)) { PH_BEGIN
        LAS float* scr = (LAS float*)(lds + wave * 16384);
        const float* an = p.in[I_ATTN_NORM]; const float* fn = p.in[I_FFN_NORM]; const float* mn = p.in[I_MEM_NORM];
        constexpr int C0 = 16 * 88, C1 = 16 * 32, C2 = 16 * 48, C3 = 16 * 32, C4 = 8 * 32, C5 = 16 * 16, C6 = 16 * 176, C7 = 44 * 32, C8 = 24, C9 = 48;
        constexpr int NITEMS = C0 + C1 + C2 + C3 + C4 + 2 * C5 + 2 * C6 + 2 * C7 + 2 * C8 + C9;
        for (int it = gw; it < NITEMS; it += ngw) {
            int r = it;
            if (r < C0) { const int nb = AIN / 32; tr_item(p.in[I_A_W_IN], AIN, an, (bf16_t*)(ws + WS_WAIN), D, 0, (r % nb) * 32, (r / nb) * 64, (r % nb) * 32, scr, lane); continue; } r -= C0;
            if (r < C1) { const int nb = 32; tr_item(p.in[I_A_W_OUT], D, nullptr, (bf16_t*)(ws + WS_WAOUT), D, 0, (r % nb) * 32, (r / nb) * 64, (r % nb) * 32, scr, lane); continue; } r -= C1;
            if (r < C2) { const int nb = 48; tr_item(p.in[I_KV_W], 1536, p.in[I_KV_NORM], (bf16_t*)(ws + WS_WIN1), D, 0, (r % nb) * 32, (r / nb) * 64, (r % nb) * 32, scr, lane); continue; } r -= C2;
            if (r < C3) { const int nb = 32; tr_item(p.in[I_B_W_IN], D, an + D, (bf16_t*)(ws + WS_WIN1), D, 0, 1536 + (r % nb) * 32, (r / nb) * 64, (r % nb) * 32, scr, lane); continue; } r -= C3;
            if (r < C4) { const int nb = 32; tr_item(p.in[I_B_W_OUT], D, nullptr, (bf16_t*)(ws + WS_WBOUT), 512, 0, (r % nb) * 32, (r / nb) * 64, (r % nb) * 32, scr, lane); continue; } r -= C4;
            if (r < 2 * C5) { const int l = r / C5; r -= l * C5; const int nb = 16; tr_item(p.in[I_MEM_W_KV] + (size_t)l * D * 512, 512, mn + l * D, (bf16_t*)(ws + WS_WMEM), D, 0, l * 512 + (r % nb) * 32, (r / nb) * 64, (r % nb) * 32, scr, lane); continue; } r -= 2 * C5;
            if (r < 2 * C6) { const int l = r / C6; r -= l * C6; const int nb = 176; const int n0 = (r % nb) * 32; const int drow = (n0 < FF) ? 256 * (n0 / 128) + (n0 % 128) : 256 * ((n0 - FF) / 128) + 128 + ((n0 - FF) % 128);
                tr_item(p.in[I_FFN_W_UP] + (size_t)l * D * FF2, FF2, fn + l * D, (bf16_t*)(ws + (l ? WS_WUP1 : WS_WUP0)), D, 0, drow, (r / nb) * 64, n0, scr, lane); continue; } r -= 2 * C6;
            if (r < 2 * C7) { const int l = r / C7; r -= l * C7; const int nb = 32; tr_item(p.in[I_FFN_W_DOWN] + (size_t)l * FF * D, D, nullptr, (bf16_t*)(ws + (l ? WS_WDN1 : WS_WDN0)), FF, 0, (r % nb) * 32, (r / nb) * 64, (r % nb) * 32, scr, lane); continue; } r -= 2 * C7;
            if (r < C8) { tr_item(p.in[I_A_W2], RW, nullptr, (bf16_t*)(ws + WS_WLORA), 256, 0, r * 32, 0, r * 32, scr, lane); continue; } r -= C8;
            if (r < C8) { tr_item(p.in[I_A_A2], RW, nullptr, (bf16_t*)(ws + WS_WLORA), 256, 64, 768 + r * 32, 0, r * 32, scr, lane); continue; } r -= C8;
            { const int nb = 24; tr_item(p.in[I_A_G2], RW, nullptr, (bf16_t*)(ws + WS_WLORA), 256, 128, 1536 + (r % nb) * 32, (r / nb) * 64, (r % nb) * 32, scr, lane); }
        }
        { bf16_t* WLr = (bf16_t*)(ws + WS_WLORA);
          for (int i = bx * 512 + tid; i < 2304 * 32; i += G * 512) { const int row = i >> 5, c8 = (i & 31) * 8; const int grp = row / 768;
              const bool nz = (grp == 0) ? (c8 < 64) : (grp == 1) ? (c8 >= 64 && c8 < 128) : (c8 >= 128);
              if (!nz) *(u32x4*)(WLr + (size_t)row * 256 + c8) = (u32x4){0u, 0u, 0u, 0u}; } }
        for (int i = bx * 512 + tid; i < T * 32; i += G * 512) { const int pos = i >> 5, f = i & 31; const float inv = powf(10000.0f, -(float)(2 * f) / 64.0f); const float ang = (float)pos * inv;
            ROPE[i] = cosf(ang); ROPE[T * 32 + i] = sinf(ang); }
        rms_pass(p.in[I_X], XN, M, gw, ngw, lane, RS);
        rms_pass(p.in[I_MEM], MEMN, NB * NMEM, gw, ngw, lane);
    }
    SYNC(0);
    if (IN(1)) {
        { pg8::Gemm g{XN, (const bf16_t*)(ws + WS_WAIN), M, AIN, D}; pg8::StaticOrder S; S.init(M, AIN, G, bx); EpiBf16 E{P, AIN, RS}; pg8::gemm_phase(lds, g, S, E); }
        { pg8::Gemm g{MEMN, (const bf16_t*)(ws + WS_WMEM), 2048, D, D}; pg8::StaticOrder S; S.init(2048, D, G, (bx + 128) % G); EpiBf16 E{MEMKV, D, nullptr}; pg8::gemm_phase(lds, g, S, E); }
    }
    SYNC(1);
    if (IN(2)) { PH_BEGIN
        const float* mu = p.in[I_A_MU];
        for (int i0 = bx * 512 + tid; i0 < M * 32; i0 += G * 512 * 4) {
            u32x4 wc_[4], wp_[4];
#pragma unroll
            for (int u = 0; u < 4; ++u) { const int i = i0 + u * G * 512; const int tok = i >> 5, lc = i & 31; const bool first = (tok & (T - 1)) == 0; const int col = 2304 + lc * 8;
                wc_[u] = *(const u32x4*)(P + (size_t)tok * AIN + col); wp_[u] = *(const u32x4*)(P + (size_t)(first ? tok : tok - 1) * AIN + col); }
#pragma unroll
            for (int u = 0; u < 4; ++u) { const int i = i0 + u * G * 512; const int tok = i >> 5, lc = i & 31; const bool first = (tok & (T - 1)) == 0; const int col = 2304 + lc * 8, q = lc >> 3;
                float pc[8], pp[8], xs[8];
                unpack8(wc_[u], pc); unpack8(wp_[u], pp);
                const f32x4 m0 = *(const f32x4*)(mu + col), m1 = *(const f32x4*)(mu + col + 4);
#pragma unroll
                for (int j = 0; j < 8; ++j) { const float pv = first ? 0.f : pp[j]; const float x = pc[j] + (pv - pc[j]) * (j < 4 ? m0[j] : m1[j - 4]); xs[j] = (q == 0) ? tanhf(x) : (q == 1) ? x : sigmoidf_(x); }
                *(u32x4*)(ACT + (size_t)tok * 256 + lc * 8) = pack8(xs); }
        }
    }
    SYNC(2);
    if (IN(3)) {
        pg8::Gemm g{ACT, (const bf16_t*)(ws + WS_WLORA), M, 2304, 256}; pg8::StaticOrder S; S.init(M, 2304, G, bx);
        EpiLora E{p.in[I_A_W0], p.in[I_A_A0], WL, AB, Gt};
        pg8::gemm_phase(lds, g, S, E);
    }
    SYNC(3);
    if (IN(4)) { PH_BEGIN
        unsigned char* CKB = (unsigned char*)out + 48 * MiB; float* SBUF = (float*)(ws + WS_SSQ);
        constexpr size_t CKWIN = (size_t)96 * WINCH * CK_BYTES;
        constexpr int NPT = 96 * (WINCH / 8);
#define PREP_TASK(pw_, u_) do { const int u__ = (u_); const int hh__ = u__ / (WINCH / 8), cw__ = (u__ % (WINCH / 8)) * 8 + wave; \
            rwkv_prep2(lds + wave * PREP_LDS, hh__, (pw_) * WINCH + cw__, CKB + (size_t)((pw_) & 1) * CKWIN + (size_t)(hh__ * WINCH + cw__) * CK_BYTES, P, WL, AB, p.in[I_A_K_K], p.in[I_A_MU], p.in[I_A_K_A], p.in[I_A_R_K], LSE, lane); } while (0)
#define XU(x_, t_) ((((x_) + 8 * ((t_) >> 2)) * 4) + ((t_) & 3))
#define TASK_OF(k_, pw_, u_, ok_) do { const int k__ = (k_); if (k__ < 2) { pw_ = 0; const int t__ = (bx >> 3) + 32 * k__; ok_ = t__ < 48; u_ = XU(bx & 7, ok_ ? t__ : 0); } \
            else { pw_ = 1 + ((k__ - 2) >> 1); u_ = XU(bx & 7, ((bx - 96) >> 3) * 2 + ((k__ - 2) & 1)); ok_ = pw_ < NWIN; } } while (0)
#define TASK_CHUNK(pw_, u_, hh_, cc_, rec_) do { hh_ = (u_) / (WINCH / 8); const int cw__ = ((u_) % (WINCH / 8)) * 8 + wave; cc_ = (pw_) * WINCH + cw__; rec_ = CKB + (size_t)((pw_) & 1) * CKWIN + (size_t)(hh_ * WINCH + cw__) * CK_BYTES; } while (0)
        if (bx >= 96) {
            int pw, u, hh, cc; bool ok; unsigned char* rec;
            for (int k = 0; k < 2 * NWIN; ++k) {
                TASK_OF(k, pw, u, ok); TASK_CHUNK(pw, u, hh, cc, rec);
                if (ok) rwkv_prep2(lds + wave * PREP_LDS, hh, cc, rec, P, WL, AB, p.in[I_A_K_K], p.in[I_A_MU], p.in[I_A_K_A], p.in[I_A_R_K], LSE, lane);
                if (k & 1) xcd_barrier(xbar);
            }
            xcd_barrier(xbar);
        } else {
            for (int t = (bx >> 3); t < 48; t += 32) PREP_TASK(0, XU(bx & 7, t));
            xcd_barrier(xbar);
            for (int win = 0; win < NWIN; ++win) {
                rwkv_seq_window(lds, bx, win, CKB + (size_t)(win & 1) * CKWIN, SBUF, Y, tid); asm volatile("s_waitcnt lgkmcnt(0)" ::: "memory"); __builtin_amdgcn_s_barrier(); asm volatile("" ::: "memory");
                if (win + 1 < NWIN && bx < 64) PREP_TASK(win + 1, XU(bx & 7, 40 + (bx >> 3)));
                xcd_barrier(xbar);
            }
        }
#undef TASK_OF
#undef XU
#undef TASK_CHUNK
#undef PREP_TASK
        {
#define MEM0_DESC(v_) AttnDesc{P + (size_t)((v_) >> 5) * T * AIN + SHIFTW + (((v_) >> 3) & 3) * 64, MEMKV + (size_t)((v_) >> 5) * NMEM * D + (((v_) >> 3) & 3) * 64, MEMKV + (size_t)((v_) >> 5) * NMEM * D + 256 + (((v_) >> 3) & 3) * 64, \
                Y + (size_t)((v_) >> 5) * T * D + RW + (((v_) >> 3) & 3) * 64, nullptr, p.in[I_MEM_Q_NORM], p.in[I_MEM_K_NORM], AIN, D, D, 0, 1, ((v_) & 7) * 4}
            AttnDesc cur = MEM0_DESC(bx); AttnRaw R; attn_issue<false>(cur, R, tid);
            for (int v = bx; v < 256; v += G) { const bool has = v + G < 256; const AttnDesc nd = MEM0_DESC(has ? v + G : v); attn_body<false>(lds, cur, R, nullptr, has, nd); cur = nd; }
#undef MEM0_DESC
        }
    }
    SYNC(4);
    if (IN(5)) { PH_BEGIN
        const float* mu = p.in[I_A_MU]; const float* lw = p.in[I_A_LNX_W]; const float* lb = p.in[I_A_LNX_B];
        for (int i0 = bx * 512 + tid; i0 < M * 96; i0 += G * 512 * 4) {
            u32x4 wy[4], wg[4], wc_[4], wp_[4]; float rk[4];
#pragma unroll
            for (int u = 0; u < 4; ++u) { const int i = i0 + u * G * 512; const int tok = i / 96, c8 = (i % 96) * 8; const bool first = (tok & (T - 1)) == 0;
                wy[u] = *(const u32x4*)(Y + (size_t)tok * D + c8); wg[u] = __builtin_nontemporal_load((const u32x4*)(Gt + (size_t)tok * RW + c8));
                wc_[u] = *(const u32x4*)(P + (size_t)tok * AIN + 1536 + c8); wp_[u] = *(const u32x4*)(P + (size_t)(first ? tok : tok - 1) * AIN + 1536 + c8);
                rk[u] = LSE[(size_t)tok * 12 + (c8 >> 6)]; }
#pragma unroll
            for (int u = 0; u < 4; ++u) { const int i = i0 + u * G * 512; const int tok = i / 96, c8 = (i % 96) * 8; const bool first = (tok & (T - 1)) == 0;
                float y[8], g[8], pc[8], pp[8];
                unpack8(wy[u], y); unpack8(wg[u], g); unpack8(wc_[u], pc); unpack8(wp_[u], pp);
                float s1 = 0.f;
#pragma unroll
                for (int j = 0; j < 8; ++j) s1 += y[j];
                const float mean = red8(s1) * (1.f / 64.f);
                float s2 = 0.f;
#pragma unroll
                for (int j = 0; j < 8; ++j) { y[j] -= mean; s2 += y[j] * y[j]; }
                const float rstd = rsqrtf(red8(s2) * (1.f / 64.f) + LNX_EPS);
                const f32x4 mA = *(const f32x4*)(mu + 1536 + c8), mB = *(const f32x4*)(mu + 1536 + c8 + 4), lwA = *(const f32x4*)(lw + c8), lwB = *(const f32x4*)(lw + c8 + 4), lbA = *(const f32x4*)(lb + c8), lbB = *(const f32x4*)(lb + c8 + 4);
                float o[8];
#pragma unroll
                for (int j = 0; j < 8; ++j) { const float pv = first ? 0.f : pp[j]; const float vv = pc[j] + (pv - pc[j]) * (j < 4 ? mA[j] : mB[j - 4]);
                    o[j] = (y[j] * rstd * (j < 4 ? lwA[j] : lwB[j - 4]) + (j < 4 ? lbA[j] : lbB[j - 4]) + rk[u] * vv) * g[j]; }
                *(u32x4*)(Y + (size_t)tok * D + c8) = pack8(o); }
        }
    }
    SYNC(5);
    if (IN(6)) { pg8::Gemm g{Y, (const bf16_t*)(ws + WS_WAOUT), M, D, D}; pg8::StaticOrder S; S.init(M, D, G, bx); EpiResid E{nullptr, XN, nullptr, XN, SSQ}; pg8::gemm_phase(lds, g, S, E); }
    SYNC(6);
#define FOR_PANELS(Nv_, BODY_) do { pg8::StaticOrder S_; S_.init(M, (Nv_), G, bx); pg8::Unit u_; int last_ = -1; for (int i_ = 0; S_.next(i_, u_); ++i_) if (u_.pm != last_) { last_ = u_.pm; const int pm_ = u_.pm; BODY_ } } while (0)
#define RS_PANEL() { if (tid < 256) { const int r_ = pm_ * 256 + tid; const f32x4* q_ = (const f32x4*)(SSQ + (size_t)r_ * 16); const f32x4 a_ = (q_[0] + q_[1]) + (q_[2] + q_[3]); \
        RS[r_] = rsqrtf(((a_[0] + a_[1]) + (a_[2] + a_[3])) * (1.f / D) + RMS_EPS); } }
    if (IN(8)) { { PH_BEGIN FOR_PANELS(FF2, RS_PANEL()); __syncthreads(); }
        pg8::Gemm g{XN, (const bf16_t*)(ws + WS_WUP0), M, FF2, D}; pg8::StaticOrder S; S.init(M, FF2, G, bx); EpiFFN E{p.in[I_FFN_CONV_W], p.in[I_FFN_CONV_B], P, (float*)(ws + WS_HU0), RS}; pg8::gemm_phase(lds, g, S, E); }
    SYNC(8);
    if (IN(10)) { { PH_BEGIN FOR_PANELS(D, { fixup_panel(tid, pm_, p.in[I_FFN_CONV_W], p.in[I_FFN_CONV_B], (const float*)(ws + WS_HU0), P); }); __syncthreads(); }
        pg8::Gemm g{P, (const bf16_t*)(ws + WS_WDN0), M, D, FF}; pg8::StaticOrder S; S.init(M, D, G, bx); EpiResid E{nullptr, XN, nullptr, XN1, SSQ}; pg8::gemm_phase(lds, g, S, E); }
    SYNC(10);
    if (IN(12)) { { PH_BEGIN FOR_PANELS(IN1, RS_PANEL()); __syncthreads(); }
        pg8::Gemm g{XN1, (const bf16_t*)(ws + WS_WIN1), M, IN1, D}; pg8::StaticOrder S; S.init(M, IN1, G, bx); EpiBf16 E{P, IN1, RS}; pg8::gemm_phase(lds, g, S, E); }
    SYNC(12);
    if (IN(13)) { PH_BEGIN
        {
#define DIL_DESC(u_, dsc) do { const int gi = (u_) >> 10, r = (u_) & 1023, b = r >> 7, hs = (r >> 5) & 3, rn = r & 31; \
                const int d = (gi == 0) ? 1 : (gi == 1) ? 4 : 16, nb = 32 / d, head = gi * 4 + hs; const bf16_t* Pb = P + (size_t)b * T * IN1; \
                dsc = AttnDesc{Pb + 1536 + head * 64, Pb + head * 64, Pb + RW + head * 64, OG + ((size_t)gi * M + (size_t)b * T) * 256 + hs * 64, LSE + ((size_t)gi * M + (size_t)b * T) * 4 + hs, \
                               p.in[I_B_Q_NORM], p.in[I_KV_K_NORM], IN1, IN1, 256, rn / nb, d, rn % nb}; } while (0)
            AttnDesc cur, nd; AttnRaw R; DIL_DESC(bx, cur); attn_issue<true>(cur, R, tid);
            for (int u = bx; u < 3072; u += G) { const bool has = u + G < 3072; DIL_DESC(has ? u + G : u, nd); attn_body<true>(lds, cur, R, ROPE, has, nd); cur = nd; }
#undef DIL_DESC
        }
        {
#define MEM1_DESC(v_) AttnDesc{P + (size_t)((v_) >> 5) * T * IN1 + 2304 + (((v_) >> 3) & 3) * 64, MEMKV + (size_t)((v_) >> 5) * NMEM * D + 512 + (((v_) >> 3) & 3) * 64, MEMKV + (size_t)((v_) >> 5) * NMEM * D + 768 + (((v_) >> 3) & 3) * 64, \
                Y1 + (size_t)((v_) >> 5) * T * 512 + 256 + (((v_) >> 3) & 3) * 64, nullptr, p.in[I_MEM_Q_NORM] + 64, p.in[I_MEM_K_NORM] + 64, IN1, D, 512, 0, 1, ((v_) & 7) * 4}
            AttnDesc cur = MEM1_DESC(bx); AttnRaw R; attn_issue<false>(cur, R, tid);
            for (int v = bx; v < 256; v += G) { const bool has = v + G < 256; const AttnDesc nd = MEM1_DESC(has ? v + G : v); attn_body<false>(lds, cur, R, nullptr, has, nd); cur = nd; }
#undef MEM1_DESC
        }
    }
    SYNC(13);
    if (IN(14)) { PH_BEGIN
        for (int i0 = bx * 512 + tid; i0 < M * 32; i0 += G * 512 * 4) {
            u32x4 wa[4], wb[4], wc_[4]; float l0[4], l1[4], l2[4];
#pragma unroll
            for (int u = 0; u < 4; ++u) { const int i = i0 + u * G * 512; const int tok = i >> 5, c8 = (i & 31) * 8, slot = c8 >> 6;
                l0[u] = LSE[((size_t)0 * M + tok) * 4 + slot]; l1[u] = LSE[((size_t)1 * M + tok) * 4 + slot]; l2[u] = LSE[((size_t)2 * M + tok) * 4 + slot];
                wa[u] = __builtin_nontemporal_load((const u32x4*)(OG + ((size_t)0 * M + tok) * 256 + c8)); wb[u] = __builtin_nontemporal_load((const u32x4*)(OG + ((size_t)1 * M + tok) * 256 + c8)); wc_[u] = __builtin_nontemporal_load((const u32x4*)(OG + ((size_t)2 * M + tok) * 256 + c8)); }
#pragma unroll
            for (int u = 0; u < 4; ++u) { const int i = i0 + u * G * 512; const int tok = i >> 5, c8 = (i & 31) * 8;
                const float mxl = fmaxf(l0[u], fmaxf(l1[u], l2[u])); const float e0 = __expf(l0[u] - mxl), e1 = __expf(l1[u] - mxl), e2 = __expf(l2[u] - mxl); const float inv = 1.f / (e0 + e1 + e2);
                float a[8], b[8], c[8], o[8];
                unpack8(wa[u], a); unpack8(wb[u], b); unpack8(wc_[u], c);
#pragma unroll
                for (int j = 0; j < 8; ++j) o[j] = (e0 * a[j] + e1 * b[j] + e2 * c[j]) * inv;
                *(u32x4*)(Y1 + (size_t)tok * 512 + c8) = pack8(o); }
        }
    }
    SYNC(14);
    if (IN(15)) { pg8::Gemm g{Y1, (const bf16_t*)(ws + WS_WBOUT), M, D, 512}; pg8::StaticOrder S; S.init(M, D, G, bx); EpiResid E{nullptr, XN1, nullptr, XN1, SSQ}; pg8::gemm_phase(lds, g, S, E); }
    SYNC(15);
    if (IN(17)) { { PH_BEGIN FOR_PANELS(FF2, RS_PANEL()); __syncthreads(); }
        pg8::Gemm g{XN1, (const bf16_t*)(ws + WS_WUP1), M, FF2, D}; pg8::StaticOrder S; S.init(M, FF2, G, bx); EpiFFN E{p.in[I_FFN_CONV_W] + 3 * FF2, p.in[I_FFN_CONV_B] + FF2, P, (float*)(ws + WS_HU1), RS}; pg8::gemm_phase(lds, g, S, E); }
    SYNC(17);
    if (IN(19)) { { PH_BEGIN FOR_PANELS(D, { fixup_panel(tid, pm_, p.in[I_FFN_CONV_W] + 3 * FF2, p.in[I_FFN_CONV_B] + FF2, (const float*)(ws + WS_HU1), P); }); __syncthreads(); }
        pg8::Gemm g{P, (const bf16_t*)(ws + WS_WDN1), M, D, FF}; pg8::StaticOrder S; S.init(M, D, G, bx); EpiResid E{nullptr, XN1, out, nullptr, nullptr}; pg8::gemm_phase(lds, g, S, E); }
#undef IN
#undef SYNC
}

extern "C" void kernel_launch(void* const* d_in, const int* in_sizes, int n_in, void* d_out, int out_size, void* d_ws, size_t ws_size, hipStream_t stream) {
    static int grid = 0;
    if (grid == 0) {
        if (n_in != 31 || ws_size < WS_END) { fprintf(stderr, "kernel_launch: unexpected n_in %d / ws %zu\n", n_in, ws_size); grid = -1; return; }
        int dev = 0, cus = 0, per_cu = 0;
        hipGetDevice(&dev); hipDeviceGetAttribute(&cus, hipDeviceAttributeMultiprocessorCount, dev);
        if (hipFuncSetAttribute((const void*)mega, hipFuncAttributeMaxDynamicSharedMemorySize, LDS_BYTES) != hipSuccess) { fprintf(stderr, "kernel_launch: hipFuncSetAttribute failed\n"); grid = -1; return; }
        if (hipOccupancyMaxActiveBlocksPerMultiprocessor(&per_cu, (const void*)mega, 512, LDS_BYTES) != hipSuccess || per_cu < 1) { fprintf(stderr, "kernel_launch: occupancy query says %d\n", per_cu); per_cu = 1; }
        (void)hipGetLastError();
        grid = cus * 1;
        if (grid > 256) grid = 256;
    }
    if (grid < 0) return;
    (void)hipMemsetAsync((char*)d_ws + WS_CTL, 0, 65536, stream);
    Params p{};
    for (int i = 0; i < 31; ++i) p.in[i] = (const float*)d_in[i];
    p.out = (float*)d_out; p.ws = (unsigned char*)d_ws; p.ph_lo = 0; p.ph_hi = NPH;
    void* args[] = {&p};
    hipError_t e = hipLaunchCooperativeKernel((const void*)mega, dim3(grid), dim3(512), args, LDS_BYTES, stream);
    if (e != hipSuccess) fprintf(stderr, "cooperative launch failed: %s (grid %d)\n", hipGetErrorString(e), grid);
}
```

```cpp
#include <hip/hip_runtime.h>
#include <hip/hip_cooperative_groups.h>
#include <cstdio>
#include <cstdint>
namespace cg = cooperative_groups;

#define LAS __attribute__((address_space(3)))
typedef unsigned short bf16_t;
typedef short bf16x8 __attribute__((ext_vector_type(8)));
typedef short s16x4 __attribute__((ext_vector_type(4)));
typedef float f32x4 __attribute__((ext_vector_type(4)));
typedef float f32x2 __attribute__((ext_vector_type(2)));
typedef unsigned u32x4 __attribute__((ext_vector_type(4)));
typedef unsigned u32x2 __attribute__((ext_vector_type(2)));
typedef __bf16 bf16x2_t __attribute__((ext_vector_type(2)));

constexpr int NB = 8, T = 4096, D = 1024, M = NB * T;
constexpr int AIN = 2816, SHIFTW = 2560, RW = 768, FF = 2816, FF2 = 5632, IN1 = 2560, NMEM = 256;
constexpr float RMS_EPS = 1e-6f, LNX_EPS = 64e-5f;

constexpr size_t MiB = 1u << 20;
constexpr size_t WS_CTL = 0;
constexpr size_t WS_WAIN = 1 * MiB;
constexpr size_t WS_WAOUT = WS_WAIN + (size_t)AIN * D * 2;
constexpr size_t WS_WIN1 = WS_WAOUT + (size_t)D * D * 2;
constexpr size_t WS_WBOUT = WS_WIN1 + (size_t)IN1 * D * 2;
constexpr size_t WS_WMEM = WS_WBOUT + (size_t)D * 512 * 2;
constexpr size_t WS_WUP0 = WS_WMEM + (size_t)D * D * 2;
constexpr size_t WS_WUP1 = WS_WUP0 + (size_t)FF2 * D * 2;
constexpr size_t WS_WDN0 = WS_WUP1 + (size_t)FF2 * D * 2;
constexpr size_t WS_WDN1 = WS_WDN0 + (size_t)D * FF * 2;
constexpr size_t WS_WLORA = WS_WDN1 + (size_t)D * FF * 2;
constexpr size_t WS_ROPE = WS_WLORA + (size_t)2304 * 256 * 2;
constexpr size_t WS_MEMN = WS_ROPE + (size_t)T * 32 * 4 * 2;
constexpr size_t WS_MEMKV = WS_MEMN + (size_t)2048 * D * 2;
constexpr size_t WS_LSE = WS_MEMKV + (size_t)2048 * D * 2;
constexpr size_t WS_SSQ = WS_LSE + (size_t)3 * M * 4 * 4;
constexpr size_t WS_RS = WS_SSQ + (size_t)M * 16 * 4;
constexpr size_t WS_WEND = WS_RS + (size_t)M * 4;
static_assert(WS_WEND <= 64 * MiB, "weight region");
constexpr size_t WS_A = 64 * MiB;
constexpr size_t WS_Y = 128 * MiB;
constexpr size_t WS_X2 = 64 * MiB;
constexpr size_t WS_P = 192 * MiB;
constexpr size_t WS_S = 368 * MiB;
constexpr size_t WS_WL = WS_S, WS_KMOD = WS_S + 48 * MiB, WS_G = WS_S + 96 * MiB;
constexpr size_t WS_HU0 = WS_S;
constexpr size_t WS_XN1 = WS_S, WS_Y1 = WS_S + 64 * MiB, WS_OG = WS_S + 96 * MiB, WS_HU1 = WS_S + 64 * MiB;
constexpr size_t WS_END = 512 * MiB;
constexpr size_t DO_KK = 0, DO_KKA = 48 * MiB, DO_ACT = 96 * MiB;

__device__ __forceinline__ unsigned cvtpk(float lo, float hi) { f32x2 v = {lo, hi}; bf16x2_t b = __builtin_convertvector(v, bf16x2_t); return __builtin_bit_cast(unsigned, b); }
__device__ __forceinline__ float bflo(unsigned w) { return __uint_as_float(w << 16); }
__device__ __forceinline__ float bfhi(unsigned w) { return __uint_as_float(w & 0xffff0000u); }
__device__ __forceinline__ float bf2f(bf16_t b) { return __uint_as_float(((unsigned)b) << 16); }
__device__ __forceinline__ bf16_t f2bf(float f) { return (bf16_t)(cvtpk(f, 0.f) & 0xffffu); }
__device__ __forceinline__ void unpack8(u32x4 w, float* o) { o[0] = bflo(w.x); o[1] = bfhi(w.x); o[2] = bflo(w.y); o[3] = bfhi(w.y); o[4] = bflo(w.z); o[5] = bfhi(w.z); o[6] = bflo(w.w); o[7] = bfhi(w.w); }
__device__ __forceinline__ u32x4 pack8(const float* v) { u32x4 w; w.x = cvtpk(v[0], v[1]); w.y = cvtpk(v[2], v[3]); w.z = cvtpk(v[4], v[5]); w.w = cvtpk(v[6], v[7]); return w; }
__device__ __forceinline__ float wave_sum(float v) {
#pragma unroll
    for (int o = 1; o < 64; o <<= 1) v += __shfl_xor(v, o);
    return v;
}
template <int CTRL> __device__ __forceinline__ float dpp_f(float x) { return __int_as_float(__builtin_amdgcn_update_dpp(0, __float_as_int(x), CTRL, 0xf, 0xf, true)); }
__device__ __forceinline__ float red8(float x) { x += dpp_f<0xB1>(x); x += dpp_f<0x4E>(x); x += dpp_f<0x141>(x); return x; }
__device__ __forceinline__ float sigmoidf_(float z) { return __builtin_amdgcn_rcpf(1.0f + __expf(-z)); }

namespace pg8 {
constexpr int BM = 256, BK = 64, HALF = 128, HTB = HALF * BK * 2, STAGE_BYTES = 8 * HTB, NXCD = 8, WGM = 8;
__host__ __device__ __forceinline__ int lds_byte(int r, int c) { const int st = (r >> 4) * 2 + (c >> 5), rr = r & 15, cc = c & 31, ob = rr * 64 + cc * 2; return st * 1024 + (ob ^ (((ob >> 9) & 1) << 5)); }
__host__ __device__ __forceinline__ void stage_rc(int b, int& R, int& C) { const int st = b / 1024, sb = b % 1024, swz = sb ^ (((sb >> 9) & 1) << 5); R = (st >> 1) * 16 + swz / 64; C = (st & 1) * 32 + (swz % 64) / 2; }
__host__ __device__ __forceinline__ int perm32(int rho) { const int n = rho >> 4, i = rho & 15; return 8 * (i >> 2) + 4 * n + (i & 3); }
struct Unit { int pm, pn; };
struct Gemm { const bf16_t* A; const bf16_t* Bt; int M, N, K; };
struct StaticOrder {
    int nM, nN, nwg, G, c;
    __device__ __forceinline__ void init(int M_, int N_, int G_, int c_) { nM = M_ / BM; nN = N_ / BM; nwg = nM * nN; G = G_; c = c_; }
    __device__ __forceinline__ bool next(int i, Unit& u) const {
        const long L = (long)i * G + c; if (L >= nwg) return false;
        int wgid = (int)L; { const int q = nwg / NXCD, r = nwg % NXCD, xcd = wgid % NXCD, off = wgid / NXCD; wgid = (xcd < r ? xcd * (q + 1) : r * (q + 1) + (xcd - r) * q) + off; }
        const int nig = WGM * nN, gid = wgid / nig, fm = gid * WGM, gsz = (nM - fm) < WGM ? (nM - fm) : WGM;
        u.pm = fm + ((wgid % nig) % gsz); u.pn = (wgid % nig) / gsz; return true;
    }
};
template <class Epi>
__device__ __forceinline__ void gemm_phase(LAS unsigned char* lds, const Gemm g, const StaticOrder& S, const Epi& E) {
    int tid = threadIdx.x; asm volatile("" : "+v"(tid));
    const int wid = __builtin_amdgcn_readfirstlane(tid >> 6), lane = tid & 63, wr = wid >> 2, wc = wid & 3, fr = lane & 15, fq = lane >> 4;
    int K_ = g.K; asm volatile("" : "+s"(K_));
    const int K = K_, nt = K / BK;
    unsigned voffA[2], voffB[2];
#pragma unroll
    for (int i = 0; i < 2; ++i) { int R, C; stage_rc(tid * 16 + i * 8192, R, C); const int Rb = Epi::PERM ? ((R & ~31) + perm32(R & 31)) : R;
        const int Ra = Epi::APERM ? (8 * (16 * (R >> 6) + (R & 15)) + ((R >> 4) & 3)) : R;
        voffA[i] = (unsigned)(Ra * K + C) * 2u; voffB[i] = (unsigned)(Rb * K + C) * 2u; }
    const size_t kstep = (size_t)(BK * 2);
    const size_t hstep = (size_t)HALF * K * 2;
    const size_t hstepA = Epi::APERM ? (size_t)4 * K * 2 : hstep;
    const size_t tstep = 2 * hstep;
    const unsigned ldsw = (unsigned)wid * 1024u;
    const int aoff = lds_byte(wr * 64 + fr, fq * 8), boff = lds_byte(wc * 32 + fr, fq * 8);
#define PG8_SA(b, h) (((b) * 2 + (h)) * HTB)
#define PG8_SB(b, h) ((4 + (b) * 2 + (h)) * HTB)
#define PG8_STAGE(bufoff, gbase, voff) do { _Pragma("unroll") for (int _i = 0; _i < 2; ++_i) \
        __builtin_amdgcn_global_load_lds((const unsigned*)((const char*)(gbase) + (voff)[_i]), (LAS unsigned*)(lds + (bufoff) + ldsw + _i * 8192), 16, 0, 0); } while (0)
#define PG8_LDA(dst, b, h) do { _Pragma("unroll") for (int m = 0; m < 4; ++m) _Pragma("unroll") for (int k = 0; k < 2; ++k) dst[m][k] = *(const LAS bf16x8*)(lds + PG8_SA(b, h) + aoff + m * 2048 + k * 1024); } while (0)
#define PG8_LDB(dst, b, h) do { _Pragma("unroll") for (int n = 0; n < 2; ++n) _Pragma("unroll") for (int k = 0; k < 2; ++k) dst[n][k] = *(const LAS bf16x8*)(lds + PG8_SB(b, h) + boff + n * 2048 + k * 1024); } while (0)
#define PG8_MMA(ai, bj, At, Bt) do { __builtin_amdgcn_s_setprio(1); _Pragma("unroll") for (int m = 0; m < 4; ++m) _Pragma("unroll") for (int n = 0; n < 2; ++n) _Pragma("unroll") for (int k = 0; k < 2; ++k) \
        acc[ai][bj][m][n] = __builtin_amdgcn_mfma_f32_16x16x32_bf16(Bt[n][k], At[m][k], acc[ai][bj][m][n], 0, 0, 0); __builtin_amdgcn_s_setprio(0); } while (0)
#define PG8_WAIT_V(n) asm volatile("s_waitcnt vmcnt(" #n ")" ::: "memory")
#define PG8_WAIT_L(n) asm volatile("s_waitcnt lgkmcnt(" #n ")" ::: "memory")
#define PG8_BAR __builtin_amdgcn_s_barrier()
#define PG8_SCHED __builtin_amdgcn_sched_barrier(0)
    Unit cur, nxt; int ui = 0;
    if (!S.next(0, cur)) return;
    f32x4 acc[2][2][4][2];
#pragma unroll
    for (int a = 0; a < 2; ++a)
#pragma unroll
        for (int b = 0; b < 2; ++b)
#pragma unroll
            for (int m = 0; m < 4; ++m)
#pragma unroll
                for (int n = 0; n < 2; ++n) acc[a][b][m][n] = (f32x4){0.f, 0.f, 0.f, 0.f};
    bf16x8 At[4][2], B0[2][2], B1[2][2];
    const char* cA = (const char*)g.A + (size_t)cur.pm * tstep; const char* cB = (const char*)g.Bt + (size_t)cur.pn * tstep;
    PG8_STAGE(PG8_SB(0, 0), cB, voffB); PG8_STAGE(PG8_SB(0, 1), cB + hstep, voffB); PG8_STAGE(PG8_SA(0, 0), cA, voffA); PG8_STAGE(PG8_SA(0, 1), cA + hstepA, voffA);
    if (wr == 1) PG8_BAR;
    PG8_WAIT_V(2); PG8_BAR;
    PG8_STAGE(PG8_SB(1, 0), cB + kstep, voffB); PG8_STAGE(PG8_SA(1, 0), cA + kstep, voffA); PG8_STAGE(PG8_SB(1, 1), cB + hstep + kstep, voffB);
    PG8_WAIT_V(6); PG8_BAR;
    for (;;) {
        const bool has_next = S.next(ui + 1, nxt);
        const char* nA = has_next ? (const char*)g.A + (size_t)nxt.pm * tstep : cA; const char* nB = has_next ? (const char*)g.Bt + (size_t)nxt.pn * tstep : cB;
        for (int t = 0; t < nt; t += 2) {
            const bool last = (t == nt - 2);
            const char* a1 = cA + (size_t)(t + 1) * kstep;
            const char* a2 = last ? nA : cA + (size_t)(t + 2) * kstep; const char* b2 = last ? nB : cB + (size_t)(t + 2) * kstep;
            const char* a3 = a2 + kstep; const char* b3 = b2 + kstep;
            PG8_LDB(B0, 0, 0); PG8_LDB(B1, 0, 1); PG8_SCHED; PG8_LDA(At, 0, 0); PG8_STAGE(PG8_SA(1, 1), a1 + hstepA, voffA);
            PG8_WAIT_V(8); PG8_WAIT_L(0); PG8_BAR; PG8_MMA(0, 0, At, B0); PG8_MMA(0, 1, At, B1); PG8_BAR; PG8_SCHED;
            PG8_LDA(At, 0, 1); PG8_STAGE(PG8_SB(0, 0), b2, voffB); PG8_STAGE(PG8_SB(0, 1), b2 + hstep, voffB); PG8_STAGE(PG8_SA(0, 0), a2, voffA);
            PG8_WAIT_V(8); PG8_WAIT_L(0); PG8_BAR; PG8_MMA(1, 0, At, B0); PG8_MMA(1, 1, At, B1); PG8_BAR; PG8_SCHED;
            PG8_LDB(B0, 1, 0); PG8_LDB(B1, 1, 1); PG8_SCHED; PG8_LDA(At, 1, 0); PG8_STAGE(PG8_SA(0, 1), a2 + hstepA, voffA);
            PG8_WAIT_V(8); PG8_WAIT_L(0); PG8_BAR; PG8_MMA(0, 0, At, B0); PG8_MMA(0, 1, At, B1); PG8_BAR; PG8_SCHED;
            PG8_LDA(At, 1, 1); PG8_STAGE(PG8_SB(1, 0), b3, voffB); PG8_STAGE(PG8_SB(1, 1), b3 + hstep, voffB); PG8_STAGE(PG8_SA(1, 0), a3, voffA);
            PG8_WAIT_V(8); PG8_WAIT_L(0); PG8_BAR; PG8_MMA(1, 0, At, B0); PG8_MMA(1, 1, At, B1); PG8_BAR; PG8_SCHED;
        }
        if (wr == 0) PG8_BAR;
        E(acc, cur, wr, wc, fr, fq);
        if (!has_next) break;
#pragma unroll
        for (int a = 0; a < 2; ++a)
#pragma unroll
            for (int b = 0; b < 2; ++b)
#pragma unroll
                for (int m = 0; m < 4; ++m)
#pragma unroll
                    for (int n = 0; n < 2; ++n) acc[a][b][m][n] = (f32x4){0.f, 0.f, 0.f, 0.f};
        cur = nxt; cA = nA; cB = nB; ++ui;
        if (wr == 1) PG8_BAR;
    }
    PG8_WAIT_V(0);
    PG8_BAR;
#undef PG8_SA
#undef PG8_SB
#undef PG8_STAGE
#undef PG8_LDA
#undef PG8_LDB
#undef PG8_MMA
#undef PG8_WAIT_V
#undef PG8_WAIT_L
#undef PG8_BAR
#undef PG8_SCHED
}
}
using pg8::Unit;

__device__ __forceinline__ float row_rs(const float* ssq, int row) {
    const f32x4* q = (const f32x4*)(ssq + (size_t)row * 16); const f32x4 a = q[0] + q[1] + q[2] + q[3];
    return rsqrtf(((a[0] + a[1]) + (a[2] + a[3])) * (1.f / D) + RMS_EPS);
}
#define ROW_SCALES8(sc, ssq_, ROWEXPR) do { f32x4 q_[8]; \
        _Pragma("unroll") for (int i_ = 0; i_ < 8; ++i_) q_[i_] = *(const f32x4*)((ssq_) + (size_t)(ROWEXPR) * 16 + 4 * fq); \
        _Pragma("unroll") for (int i_ = 0; i_ < 8; ++i_) { float s_ = (q_[i_][0] + q_[i_][1]) + (q_[i_][2] + q_[i_][3]); s_ += __shfl_xor(s_, 16); s_ += __shfl_xor(s_, 32); sc[i_] = rsqrtf(s_ * (1.f / D) + RMS_EPS); } } while (0)
struct EpiBf16 {
    static constexpr bool PERM = true, APERM = false;
    bf16_t* O; int ldc; const float* ssq;
    __device__ __forceinline__ void operator()(f32x4 (&acc)[2][2][4][2], const Unit& u, int wr, int wc, int fr, int fq) const {
        const int row0 = u.pm * 256 + wr * 64 + fr, col0 = u.pn * 256 + wc * 32 + 8 * fq;
        float scs[8];
#pragma unroll
        for (int i = 0; i < 8; ++i) scs[i] = ssq ? ssq[row0 + (i >> 2) * 128 + (i & 3) * 16] : 1.0f;
#pragma unroll
        for (int ai = 0; ai < 2; ++ai)
#pragma unroll
            for (int m = 0; m < 4; ++m) { const int row = row0 + ai * 128 + m * 16; bf16_t* rowp = O + (size_t)row * ldc + col0;
                const float sc = scs[ai * 4 + m];
#pragma unroll
                for (int bj = 0; bj < 2; ++bj) { const f32x4 v0 = acc[ai][bj][m][0] * sc, v1 = acc[ai][bj][m][1] * sc;
                    u32x4 w; w.x = cvtpk(v0[0], v0[1]); w.y = cvtpk(v0[2], v0[3]); w.z = cvtpk(v1[0], v1[1]); w.w = cvtpk(v1[2], v1[3]);
                    *(u32x4*)(rowp + bj * 128) = w; } }
    }
};
struct EpiResid {
    static constexpr bool PERM = true, APERM = false;
    const float* base; const bf16_t* baseb; float* out; bf16_t* XB; float* SSQ;
    __device__ __forceinline__ void operator()(f32x4 (&acc)[2][2][4][2], const Unit& u, int wr, int wc, int fr, int fq) const {
        const int row0 = u.pm * 256 + wr * 64 + fr, col0 = u.pn * 256 + wc * 32 + 8 * fq;
#pragma unroll
        for (int ai = 0; ai < 2; ++ai) {
            f32x4 bv[4][2][2];
#pragma unroll
            for (int m = 0; m < 4; ++m) { const size_t off = (size_t)(row0 + ai * 128 + m * 16) * D + col0;
#pragma unroll
                for (int bj = 0; bj < 2; ++bj) {
                    if (baseb) { const u32x4 w = *(const u32x4*)(baseb + off + bj * 128); bv[m][bj][0] = (f32x4){bflo(w.x), bfhi(w.x), bflo(w.y), bfhi(w.y)}; bv[m][bj][1] = (f32x4){bflo(w.z), bfhi(w.z), bflo(w.w), bfhi(w.w)}; }
                    else { bv[m][bj][0] = *(const f32x4*)(base + off + bj * 128); bv[m][bj][1] = *(const f32x4*)(base + off + bj * 128 + 4); } } }
            asm volatile("" ::: "memory");
#pragma unroll
            for (int m = 0; m < 4; ++m) { const int row = row0 + ai * 128 + m * 16; const size_t off = (size_t)row * D + col0; float ss = 0.f;
#pragma unroll
                for (int bj = 0; bj < 2; ++bj) {
                    const f32x4 o0 = bv[m][bj][0] + acc[ai][bj][m][0], o1 = bv[m][bj][1] + acc[ai][bj][m][1];
                    if (out) { __builtin_nontemporal_store(o0, (f32x4*)(out + off + bj * 128)); __builtin_nontemporal_store(o1, (f32x4*)(out + off + bj * 128 + 4)); }
                    if (XB) { u32x4 w; w.x = cvtpk(o0[0], o0[1]); w.y = cvtpk(o0[2], o0[3]); w.z = cvtpk(o1[0], o1[1]); w.w = cvtpk(o1[2], o1[3]); *(u32x4*)(XB + off + bj * 128) = w;
                        ss += (o0[0] * o0[0] + o0[1] * o0[1]) + (o0[2] * o0[2] + o0[3] * o0[3]) + (o1[0] * o1[0] + o1[1] * o1[1]) + (o1[2] * o1[2] + o1[3] * o1[3]); } }
                if (XB) { ss += __shfl_xor(ss, 16); ss += __shfl_xor(ss, 32); if (fq == 0) SSQ[(size_t)row * 16 + u.pn * 4 + wc] = ss; } }
            asm volatile("" ::: "memory");
        }
    }
};
struct EpiLora {
    static constexpr bool PERM = true, APERM = false;
    const float *w0, *a0; unsigned short* WL; bf16_t* AB; bf16_t* G;
    __device__ __forceinline__ void operator()(f32x4 (&acc)[2][2][4][2], const Unit& u, int wr, int wc, int fr, int fq) const {
        const int kind = u.pn / 3, row0 = u.pm * 256 + wr * 64 + fr;
#pragma unroll
        for (int bj = 0; bj < 2; ++bj) {
            const int c = (u.pn % 3) * 256 + bj * 128 + wc * 32 + 8 * fq;
            if (kind == 2) {
#pragma unroll
                for (int ai = 0; ai < 2; ++ai)
#pragma unroll
                    for (int m = 0; m < 4; ++m) { const int row = row0 + ai * 128 + m * 16; const f32x4 v0 = acc[ai][bj][m][0], v1 = acc[ai][bj][m][1];
                        u32x4 w; w.x = cvtpk(v0[0], v0[1]); w.y = cvtpk(v0[2], v0[3]); w.z = cvtpk(v1[0], v1[1]); w.w = cvtpk(v1[2], v1[3]);
                        *(u32x4*)(G + (size_t)row * RW + c) = w; }
            } else {
                const float* bp = (kind == 0 ? w0 : a0) + c;
                const f32x4 b0 = *(const f32x4*)bp, b1 = *(const f32x4*)(bp + 4);
#pragma unroll
                for (int ai = 0; ai < 2; ++ai)
#pragma unroll
                    for (int m = 0; m < 4; ++m) { const int row = row0 + ai * 128 + m * 16; float sg[8];
#pragma unroll
                        for (int j = 0; j < 4; ++j) { sg[j] = sigmoidf_(b0[j] + acc[ai][bj][m][0][j]); sg[4 + j] = sigmoidf_(b1[j] + acc[ai][bj][m][1][j]); }
                        if (kind == 0) { unsigned short h[8];
#pragma unroll
                            for (int j = 0; j < 8; ++j) h[j] = __builtin_bit_cast(unsigned short, (_Float16)(-0.60653066f * sg[j]));
                            u32x4 w; w.x = h[0] | ((unsigned)h[1] << 16); w.y = h[2] | ((unsigned)h[3] << 16); w.z = h[4] | ((unsigned)h[5] << 16); w.w = h[6] | ((unsigned)h[7] << 16);
                            *(u32x4*)(WL + (size_t)row * RW + c) = w; }
                        else *(u32x4*)(AB + (size_t)row * RW + c) = pack8(sg); }
            }
        }
    }
};
struct EpiFFN {
    static constexpr bool PERM = true, APERM = true;
    const float* cw; const float* cb; bf16_t* Z; float* HU; const float* ssq;
    __device__ __forceinline__ void operator()(f32x4 (&acc)[2][2][4][2], const Unit& u, int wr, int wc, int fr, int fq) const {
        f32x4 prm[2][8];
#pragma unroll
        for (int n = 0; n < 2; ++n) { const int c = u.pn * 128 + wc * 32 + 8 * fq + 4 * n;
            prm[n][0] = *(const f32x4*)(cw + c); prm[n][1] = *(const f32x4*)(cw + FF2 + c); prm[n][2] = *(const f32x4*)(cw + 2 * FF2 + c); prm[n][3] = *(const f32x4*)(cb + c);
            prm[n][4] = *(const f32x4*)(cw + FF + c); prm[n][5] = *(const f32x4*)(cw + FF2 + FF + c); prm[n][6] = *(const f32x4*)(cw + 2 * FF2 + FF + c); prm[n][7] = *(const f32x4*)(cb + FF + c); }
        if (ssq) { const int rowb = u.pm * 256 + 8 * (16 * wr + fr);
            const f32x4 sA = *(const f32x4*)(ssq + rowb), sB = *(const f32x4*)(ssq + rowb + 4);
            const float sc[8] = {sA[0], sA[1], sA[2], sA[3], sB[0], sB[1], sB[2], sB[3]};
#pragma unroll
            for (int i = 0; i < 8; ++i)
#pragma unroll
                for (int bj = 0; bj < 2; ++bj)
#pragma unroll
                    for (int n = 0; n < 2; ++n) acc[i >> 2][bj][i & 3][n] *= sc[i]; }
        const int rowb = u.pm * 256 + 8 * (16 * wr + fr);
        const int grp = u.pm * 2 + wr, c0 = u.pn * 128 + wc * 32 + 8 * fq;
#define FFN_Z(n, UG, UV, UG1, UV1, UG2, UV2, W0, W1) { const f32x4 cgv = prm[n][3] + prm[n][0] * (UG2) + prm[n][1] * (UG1) + prm[n][2] * (UG), cvv = prm[n][7] + prm[n][4] * (UV2) + prm[n][5] * (UV1) + prm[n][6] * (UV); \
            W0 = cvtpk(cgv[0] * sigmoidf_(cgv[0]) * cvv[0], cgv[1] * sigmoidf_(cgv[1]) * cvv[1]); W1 = cvtpk(cgv[2] * sigmoidf_(cgv[2]) * cvv[2], cgv[3] * sigmoidf_(cgv[3]) * cvv[3]); }
        u32x4 z0, z1;
#define FFN_HEAD(n, A, B) { const int c = c0 + 4 * n; \
            if (fr == 0) { float* h = HU + ((size_t)grp * 4) * FF2; *(f32x4*)(h + c) = acc[0][0][0][n]; *(f32x4*)(h + FF + c) = acc[0][1][0][n]; *(f32x4*)(h + FF2 + c) = acc[0][0][1][n]; *(f32x4*)(h + FF2 + FF + c) = acc[0][1][1][n]; } \
            if (fr == 15) { float* h = HU + ((size_t)grp * 4 + 2) * FF2; *(f32x4*)(h + c) = acc[1][0][2][n]; *(f32x4*)(h + FF + c) = acc[1][1][2][n]; *(f32x4*)(h + FF2 + c) = acc[1][0][3][n]; *(f32x4*)(h + FF2 + FF + c) = acc[1][1][3][n]; } \
            f32x4 pg6, pg7, pv6, pv7; \
            _Pragma("unroll") for (int j = 0; j < 4; ++j) { pg6[j] = dpp_f<0x111>(acc[1][0][2][n][j]); pg7[j] = dpp_f<0x111>(acc[1][0][3][n][j]); pv6[j] = dpp_f<0x111>(acc[1][1][2][n][j]); pv7[j] = dpp_f<0x111>(acc[1][1][3][n][j]); } \
            FFN_Z(n, acc[0][0][0][n], acc[0][1][0][n], pg7, pv7, pg6, pv6, z0.A, z0.B) \
            FFN_Z(n, acc[0][0][1][n], acc[0][1][1][n], acc[0][0][0][n], acc[0][1][0][n], pg7, pv7, z1.A, z1.B) }
        FFN_HEAD(0, x, y) asm volatile("" : "+v"(z0), "+v"(z1) : : "memory"); FFN_HEAD(1, z, w)
        if (fr != 0) { *(u32x4*)(Z + (size_t)(rowb + 0) * FF + c0) = z0; *(u32x4*)(Z + (size_t)(rowb + 1) * FF + c0) = z1; }
#define FFN_ROW16(i, a_, m_, a1_, m1_, a2_, m2_) { u32x4 zz; \
            FFN_Z(0, acc[a_][0][m_][0], acc[a_][1][m_][0], acc[a1_][0][m1_][0], acc[a1_][1][m1_][0], acc[a2_][0][m2_][0], acc[a2_][1][m2_][0], zz.x, zz.y) \
            FFN_Z(1, acc[a_][0][m_][1], acc[a_][1][m_][1], acc[a1_][0][m1_][1], acc[a1_][1][m1_][1], acc[a2_][0][m2_][1], acc[a2_][1][m2_][1], zz.z, zz.w) \
            *(u32x4*)(Z + (size_t)(rowb + (i)) * FF + c0) = zz; }
        asm volatile("" ::: "memory");
        FFN_ROW16(2, 0, 2, 0, 1, 0, 0)
        asm volatile("" ::: "memory");
        FFN_ROW16(3, 0, 3, 0, 2, 0, 1)
        asm volatile("" ::: "memory");
        FFN_ROW16(4, 1, 0, 0, 3, 0, 2)
        asm volatile("" ::: "memory");
        FFN_ROW16(5, 1, 1, 1, 0, 0, 3)
        asm volatile("" ::: "memory");
        FFN_ROW16(6, 1, 2, 1, 1, 1, 0)
        asm volatile("" ::: "memory");
        FFN_ROW16(7, 1, 3, 1, 2, 1, 1)
#undef FFN_ROW16
#undef FFN_HEAD
#undef FFN_Z
    }
};

struct Params { const float* in[31]; float* out; unsigned char* ws; int ph_lo, ph_hi; };
enum { I_X = 0, I_MEM, I_ATTN_NORM, I_A_W_IN, I_A_MU, I_A_W0, I_A_W2, I_A_A0, I_A_A2, I_A_G2, I_A_K_K, I_A_K_A, I_A_R_K, I_A_LNX_W, I_A_LNX_B, I_A_W_OUT,
       I_KV_NORM, I_KV_W, I_KV_K_NORM, I_B_W_IN, I_B_Q_NORM, I_B_W_OUT, I_MEM_NORM, I_MEM_W_KV, I_MEM_Q_NORM, I_MEM_K_NORM, I_FFN_NORM, I_FFN_W_UP, I_FFN_CONV_W, I_FFN_CONV_B, I_FFN_W_DOWN };

__device__ __forceinline__ void tr_item(const float* W, int N, const float* gain, bf16_t* WT, int ldk, int koff, int drow0, int k0, int n0, LAS float* scr, int lane) {
    float wv[32];
#pragma unroll
    for (int i = 0; i < 32; ++i) { const int kk = 2 * i + (lane >> 5); wv[i] = __builtin_nontemporal_load(W + (size_t)(k0 + kk) * N + n0 + (lane & 31)); }
    if (gain) {
#pragma unroll
        for (int i = 0; i < 32; ++i) wv[i] *= gain[k0 + 2 * i + (lane >> 5)]; }
#pragma unroll
    for (int i = 0; i < 32; ++i) { const int kk = 2 * i + (lane >> 5); scr[kk * 33 + (lane & 31)] = wv[i]; }
    asm volatile("s_waitcnt lgkmcnt(0)" ::: "memory");
    const int c = lane & 7;
#pragma unroll
    for (int j = 0; j < 4; ++j) { const int n = (lane >> 3) + 8 * j; const LAS float* s = scr + (8 * c) * 33 + n;
        u32x4 o; o.x = cvtpk(s[0 * 33], s[1 * 33]); o.y = cvtpk(s[2 * 33], s[3 * 33]); o.z = cvtpk(s[4 * 33], s[5 * 33]); o.w = cvtpk(s[6 * 33], s[7 * 33]);
        *(u32x4*)(WT + (size_t)(drow0 + n) * ldk + koff + k0 + 8 * c) = o; }
    asm volatile("s_waitcnt lgkmcnt(0)" ::: "memory");
}
__device__ __forceinline__ void rms_row_to_bf16(const float* xrow, bf16_t* orow, int lane) {
    const f32x4* xr = (const f32x4*)xrow + lane;
    f32x4 v[4]; float s = 0.f;
#pragma unroll
    for (int j = 0; j < 4; ++j) { v[j] = xr[64 * j]; s += (v[j].x * v[j].x + v[j].y * v[j].y) + (v[j].z * v[j].z + v[j].w * v[j].w); }
    const float rs = rsqrtf(wave_sum(s) * (1.f / D) + RMS_EPS);
    u32x2* o8 = (u32x2*)orow + lane;
#pragma unroll
    for (int j = 0; j < 4; ++j) { u32x2 w; w.x = cvtpk(v[j].x * rs, v[j].y * rs); w.y = cvtpk(v[j].z * rs, v[j].w * rs); o8[64 * j] = w; }
}
__device__ __forceinline__ void rms_pass(const float* X, bf16_t* O, int rows, int gw, int ngw, int lane_, float* RSout = nullptr) {
    int lane = lane_; asm volatile("" : "+v"(lane));
    for (int m0 = gw * 4; m0 < rows; m0 += ngw * 4) {
        f32x4 v[4][4]; float s[4];
#pragma unroll
        for (int u = 0; u < 4; ++u) { const f32x4* xr = (const f32x4*)(X + (size_t)(m0 + u) * D) + lane;
#pragma unroll
            for (int j = 0; j < 4; ++j) v[u][j] = __builtin_nontemporal_load(xr + 64 * j); }
#pragma unroll
        for (int u = 0; u < 4; ++u) { s[u] = 0.f;
#pragma unroll
            for (int j = 0; j < 4; ++j) s[u] += (v[u][j].x * v[u][j].x + v[u][j].y * v[u][j].y) + (v[u][j].z * v[u][j].z + v[u][j].w * v[u][j].w); }
#pragma unroll
        for (int o = 1; o < 64; o <<= 1) {
#pragma unroll
            for (int u = 0; u < 4; ++u) s[u] += __shfl_xor(s[u], o); }
#pragma unroll
        for (int u = 0; u < 4; ++u) { float rs = rsqrtf(s[u] * (1.f / D) + RMS_EPS); if (RSout) { if (lane == 0) RSout[m0 + u] = rs; rs = 1.0f; } u32x2* o8 = (u32x2*)(O + (size_t)(m0 + u) * D) + lane;
#pragma unroll
            for (int j = 0; j < 4; ++j) { u32x2 w; w.x = cvtpk(v[u][j].x * rs, v[u][j].y * rs); w.y = cvtpk(v[u][j].z * rs, v[u][j].w * rs); o8[64 * j] = w; } }
    }
}

constexpr int KS_STRIDE = 144, VT_STRIDE = 528, KS_BYTES = 256 * KS_STRIDE, VT_BYTES = 64 * VT_STRIDE;
struct AttnDesc { const bf16_t* Qb; const bf16_t* Kb; const bf16_t* Vb; bf16_t* Ob; float* lse; const float* qgain; const float* kgain; int qpitch, kvpitch, opitch, rho, d, n; };
struct AttnRaw { u32x4 k1a, k2a, k1b, k2b, v0, v1, v2, v3, q1, q2; };
template <bool DIL>
__device__ __forceinline__ void attn_issue(const AttnDesc& a, AttnRaw& R, int tid) {
    const u32x4 z = (u32x4){0u, 0u, 0u, 0u};
#define AT_KLD(it_, K1, K2) do { const int item = tid + 512 * (it_), jj = item >> 2, c = item & 3; const int sub = DIL ? (a.n - 1) * 128 + jj : jj; const int pos = DIL ? a.rho + a.d * sub : jj; \
        K1 = z; K2 = z; if (sub >= 0) { const bf16_t* kp = a.Kb + (size_t)pos * a.kvpitch; K1 = *(const u32x4*)(kp + c * 8); K2 = *(const u32x4*)(kp + 32 + c * 8); } } while (0)
#define AT_VLD(it_, V) do { const int item = tid + 512 * (it_), jj = item >> 3, c = item & 7; const int sub = DIL ? (a.n - 1) * 128 + jj : jj; const int pos = DIL ? a.rho + a.d * sub : jj; \
        V = z; if (sub >= 0) V = *(const u32x4*)(a.Vb + (size_t)pos * a.kvpitch + c * 8); } while (0)
    AT_KLD(0, R.k1a, R.k2a); AT_KLD(1, R.k1b, R.k2b); AT_VLD(0, R.v0); AT_VLD(1, R.v1); AT_VLD(2, R.v2); AT_VLD(3, R.v3);
#undef AT_KLD
#undef AT_VLD
    { const int wave = tid >> 6, lane = tid & 63, iq = 16 * wave + (lane & 15), Q = lane >> 4; const int qpos = DIL ? a.rho + a.d * (a.n * 128 + iq) : a.n * 128 + iq;
      const bf16_t* qp = a.Qb + (size_t)qpos * a.qpitch; R.q1 = *(const u32x4*)(qp + Q * 8); R.q2 = *(const u32x4*)(qp + 32 + Q * 8); }
}
template <bool DIL>
__device__ __forceinline__ void attn_body(LAS unsigned char* lds, const AttnDesc& a, AttnRaw& R, const float* rope, bool has_next, const AttnDesc& nxt) {
    constexpr int NT = DIL ? 10 : 16;
    int tid = threadIdx.x; asm volatile("" : "+v"(tid));
    const int wave = tid >> 6, lane = tid & 63, lr = lane & 15, Q = lane >> 4;
    const int rho = a.rho, d = a.d, n = a.n; const float* kgain = a.kgain; const float* qgain = a.qgain;
    LAS unsigned char* Ks = lds; LAS unsigned char* Vt = lds + KS_BYTES;
#define AT_KST(it_, K1, K2) do { const int item = tid + 512 * (it_), jj = item >> 2, c = item & 3; \
        const int sub = DIL ? (n - 1) * 128 + jj : jj; const bool valid = sub >= 0; const int pos = DIL ? rho + d * sub : jj; \
        float x1[8], x2[8]; unpack8(K1, x1); unpack8(K2, x2); \
        float ss = 0.f; \
        _Pragma("unroll") for (int i = 0; i < 8; ++i) ss += x1[i] * x1[i] + x2[i] * x2[i]; \
        ss += __shfl_xor(ss, 1); ss += __shfl_xor(ss, 2); \
        const float rs = rsqrtf(ss * (1.f / 64.f) + RMS_EPS); \
        float o1[8], o2[8], g1[8], g2[8], cs[8], sn[8]; \
        *(f32x4*)g1 = *(const f32x4*)(kgain + c * 8); *(f32x4*)(g1 + 4) = *(const f32x4*)(kgain + c * 8 + 4); *(f32x4*)g2 = *(const f32x4*)(kgain + 32 + c * 8); *(f32x4*)(g2 + 4) = *(const f32x4*)(kgain + 32 + c * 8 + 4); \
        if (DIL) { const int pz = valid ? pos : 0; *(f32x4*)cs = *(const f32x4*)(rope + pz * 32 + c * 8); *(f32x4*)(cs + 4) = *(const f32x4*)(rope + pz * 32 + c * 8 + 4); \
            *(f32x4*)sn = *(const f32x4*)(rope + T * 32 + pz * 32 + c * 8); *(f32x4*)(sn + 4) = *(const f32x4*)(rope + T * 32 + pz * 32 + c * 8 + 4); } \
        _Pragma("unroll") for (int i = 0; i < 8; ++i) { const float aa = x1[i] * rs * g1[i], bb = x2[i] * rs * g2[i]; \
            if (DIL) { o1[i] = aa * cs[i] - bb * sn[i]; o2[i] = bb * cs[i] + aa * sn[i]; } else { o1[i] = aa; o2[i] = bb; } } \
        *(LAS u32x4*)(Ks + jj * KS_STRIDE + c * 16) = pack8(o1); *(LAS u32x4*)(Ks + jj * KS_STRIDE + 64 + c * 16) = pack8(o2); } while (0)
    AT_KST(0, R.k1a, R.k2a); AT_KST(1, R.k1b, R.k2b);
#undef AT_KST
#define AT_VST(it_, V) do { const int item = tid + 512 * (it_), jj = item >> 3, c = item & 7; const unsigned ww[4] = {V.x, V.y, V.z, V.w}; \
        _Pragma("unroll") for (int i = 0; i < 4; ++i) { *(LAS unsigned short*)(Vt + (c * 8 + 2 * i) * VT_STRIDE + jj * 2) = (unsigned short)(ww[i] & 0xffffu); *(LAS unsigned short*)(Vt + (c * 8 + 2 * i + 1) * VT_STRIDE + jj * 2) = (unsigned short)(ww[i] >> 16); } } while (0)
    AT_VST(0, R.v0); AT_VST(1, R.v1); AT_VST(2, R.v2); AT_VST(3, R.v3);
#undef AT_VST
    constexpr int NQ = DIL ? 1 : 4;
    const int iq = 16 * wave + lr;
    bf16_t* Ob = a.Ob; const int opitch = a.opitch; float* lse = a.lse;
    for (int nn = 0; nn < NQ; ++nn) {
    const int qpos = DIL ? rho + d * (n * 128 + iq) : (n + nn) * 128 + iq;
    bf16x8 bq1, bq2;
    { float x1[8], x2[8]; unpack8(R.q1, x1); unpack8(R.q2, x2);
      float ss = 0.f;
#pragma unroll
      for (int i = 0; i < 8; ++i) ss += x1[i] * x1[i] + x2[i] * x2[i];
      ss += __shfl_xor(ss, 16); ss += __shfl_xor(ss, 32);
      const float rs = rsqrtf(ss * (1.f / 64.f) + RMS_EPS);
      float o1[8], o2[8], g1[8], g2[8], cs[8], sn[8];
      *(f32x4*)g1 = *(const f32x4*)(qgain + Q * 8); *(f32x4*)(g1 + 4) = *(const f32x4*)(qgain + Q * 8 + 4); *(f32x4*)g2 = *(const f32x4*)(qgain + 32 + Q * 8); *(f32x4*)(g2 + 4) = *(const f32x4*)(qgain + 32 + Q * 8 + 4);
      if (DIL) { *(f32x4*)cs = *(const f32x4*)(rope + qpos * 32 + Q * 8); *(f32x4*)(cs + 4) = *(const f32x4*)(rope + qpos * 32 + Q * 8 + 4);
          *(f32x4*)sn = *(const f32x4*)(rope + T * 32 + qpos * 32 + Q * 8); *(f32x4*)(sn + 4) = *(const f32x4*)(rope + T * 32 + qpos * 32 + Q * 8 + 4); }
#pragma unroll
      for (int i = 0; i < 8; ++i) { const float aa = x1[i] * rs * g1[i], bb = x2[i] * rs * g2[i];
          if (DIL) { o1[i] = (aa * cs[i] - bb * sn[i]) * 0.125f; o2[i] = (bb * cs[i] + aa * sn[i]) * 0.125f; }
          else { o1[i] = aa * 0.125f; o2[i] = bb * 0.125f; } }
      bq1 = __builtin_bit_cast(bf16x8, pack8(o1)); bq2 = __builtin_bit_cast(bf16x8, pack8(o2)); }
    if (nn == 0) { asm volatile("s_waitcnt lgkmcnt(0)" ::: "memory"); __builtin_amdgcn_s_barrier(); asm volatile("" ::: "memory"); }
    if (nn + 1 < NQ) { const bf16_t* qp = a.Qb + (size_t)(qpos + 128) * a.qpitch; R.q1 = *(const u32x4*)(qp + Q * 8); R.q2 = *(const u32x4*)(qp + 32 + Q * 8); }
    else if (has_next) attn_issue<DIL>(nxt, R, tid);
    const int kt0 = DIL ? (wave < 6 ? wave : 6) : 0;
    f32x4 s[NT];
#pragma unroll
    for (int kt = 0; kt < NT; ++kt) { const LAS unsigned char* kp = Ks + (16 * (kt0 + kt) + lr) * KS_STRIDE + Q * 16;
        const bf16x8 a1 = *(const LAS bf16x8*)kp, a2 = *(const LAS bf16x8*)(kp + 64);
        f32x4 z = (f32x4){0.f, 0.f, 0.f, 0.f};
        z = __builtin_amdgcn_mfma_f32_16x16x32_bf16(a1, bq1, z, 0, 0, 0); s[kt] = __builtin_amdgcn_mfma_f32_16x16x32_bf16(a2, bq2, z, 0, 0, 0); }
    float mx = -3.0e38f;
#pragma unroll
    for (int kt = 0; kt < NT; ++kt)
#pragma unroll
        for (int j = 0; j < 4; ++j) { if (DIL) { const int jj = 16 * (kt0 + kt) + 4 * Q + j; const bool ok = (jj >= iq) && (jj <= iq + 128) && (n > 0 || jj >= 128); if (!ok) s[kt][j] = -1e30f; } mx = fmaxf(mx, s[kt][j]); }
    mx = fmaxf(mx, __shfl_xor(mx, 16)); mx = fmaxf(mx, __shfl_xor(mx, 32));
    float den = 0.f;
#pragma unroll
    for (int kt = 0; kt < NT; ++kt)
#pragma unroll
        for (int j = 0; j < 4; ++j) { const float e = __expf(s[kt][j] - mx); s[kt][j] = e; den += e; }
    den += __shfl_xor(den, 16); den += __shfl_xor(den, 32);
    f32x4 o[4];
#pragma unroll
    for (int dt = 0; dt < 4; ++dt) o[dt] = (f32x4){0.f, 0.f, 0.f, 0.f};
#pragma unroll
    for (int p2 = 0; p2 < NT / 2; ++p2) {
        u32x4 pb; pb.x = cvtpk(s[2 * p2][0], s[2 * p2][1]); pb.y = cvtpk(s[2 * p2][2], s[2 * p2][3]); pb.z = cvtpk(s[2 * p2 + 1][0], s[2 * p2 + 1][1]); pb.w = cvtpk(s[2 * p2 + 1][2], s[2 * p2 + 1][3]);
        const bf16x8 b = __builtin_bit_cast(bf16x8, pb);
#pragma unroll
        for (int dt = 0; dt < 4; ++dt) { const LAS unsigned char* vp = Vt + (16 * dt + lr) * VT_STRIDE + (16 * (kt0 + 2 * p2) + 4 * Q) * 2;
            const u32x2 lo = *(const LAS u32x2*)vp, hi = *(const LAS u32x2*)(vp + 32);
            const u32x4 av = (u32x4){lo.x, lo.y, hi.x, hi.y};
            o[dt] = __builtin_amdgcn_mfma_f32_16x16x32_bf16(__builtin_bit_cast(bf16x8, av), b, o[dt], 0, 0, 0); }
    }
    const float inv = __builtin_amdgcn_rcpf(den);
    bf16_t* op = Ob + (size_t)qpos * opitch;
#pragma unroll
    for (int dt = 0; dt < 4; ++dt) { u32x2 w; w.x = cvtpk(o[dt][0] * inv, o[dt][1] * inv); w.y = cvtpk(o[dt][2] * inv, o[dt][3] * inv); *(u32x2*)(op + 16 * dt + 4 * Q) = w; }
    if (DIL && Q == 0) lse[(size_t)qpos * 4] = mx + __logf(den);
    }
    asm volatile("s_waitcnt lgkmcnt(0)" ::: "memory"); __builtin_amdgcn_s_barrier(); asm volatile("" ::: "memory");
}

constexpr int TC = 32;
__device__ __forceinline__ float red16(float x) { x += dpp_f<0xB1>(x); x += dpp_f<0x4E>(x); x += dpp_f<0x141>(x); x += dpp_f<0x140>(x); return x; }
struct ScanOps { f32x4 kk, w, ka, k, r; float v; };
__device__ __forceinline__ float h2f(unsigned short h) { return (float)__builtin_bit_cast(_Float16, h); }
__device__ __forceinline__ void scan_half(LAS unsigned char* lds, int hb, const bf16_t* P, const unsigned short* WL, const bf16_t* AB, const bf16_t* KKb,
                                          const float* mu, const float* k_a, const float* r_k, float* RK, bf16_t* Y) {
    int tid = threadIdx.x; asm volatile("" : "+v"(tid));
    const int wave = __builtin_amdgcn_readfirstlane(tid >> 6), lane = tid & 63;
    const int hh = hb >> 1, half = hb & 1, b = hh / 12, h = hh % 12;
    const size_t tok0 = (size_t)b * T;
    LAS float* bufs = (LAS float*)lds;
    LAS float* vbuf = (LAS float*)(lds + 81920 + 1024);
    LAS float* ys = (LAS float*)(lds + 81920 + 1024 + 8192 + 1024);
    constexpr int NCH = T / TC;
    const int sel = tid >> 8, li = tid & 255, lrow = li >> 3, c8 = (li & 7) * 8, ch = h * 64 + c8;
    const int lrv = (li >> 2) & 31, cv = 1536 + h * 64 + 32 * half + (li & 3) * 8;
    float m0[8], m1[8], ka8[8], rk8[8];
    { const float* pa = sel ? mu + cv : mu + ch; *(f32x4*)m0 = *(const f32x4*)pa; *(f32x4*)(m0 + 4) = *(const f32x4*)(pa + 4); }
    *(f32x4*)m1 = *(const f32x4*)(mu + RW + ch); *(f32x4*)(m1 + 4) = *(const f32x4*)(mu + RW + ch + 4);
    *(f32x4*)ka8 = *(const f32x4*)(k_a + ch); *(f32x4*)(ka8 + 4) = *(const f32x4*)(k_a + ch + 4);
    *(f32x4*)rk8 = *(const f32x4*)(r_k + ch); *(f32x4*)(rk8 + 4) = *(const f32x4*)(r_k + ch + 4);
    u32x4 q0, q1, q2, q3, q4, q5;
    const bool vthr = (sel == 1) && (li < 128);
#define SCAN_ISSUE(cc_) do { const size_t tok = tok0 + (size_t)(cc_) * TC + lrow; const size_t tokp = ((cc_) == 0 && lrow == 0) ? tok : tok - 1; \
        if (sel == 0) { q0 = *(const u32x4*)(P + tok * AIN + ch); q1 = *(const u32x4*)(P + tokp * AIN + ch); q2 = *(const u32x4*)(P + tok * AIN + RW + ch); q3 = *(const u32x4*)(P + tokp * AIN + RW + ch); \
            q4 = *(const u32x4*)(AB + tok * RW + ch); q5 = *(const u32x4*)(KKb + tok * RW + ch); } \
        else { q0 = *(const u32x4*)(WL + tok * RW + ch); \
            if (vthr) { const size_t tv = tok0 + (size_t)(cc_) * TC + lrv; const size_t tvp = ((cc_) == 0 && lrv == 0) ? tv : tv - 1; q1 = *(const u32x4*)(P + tv * AIN + cv); q2 = *(const u32x4*)(P + tvp * AIN + cv); } } } while (0)
#define ST8(dst, a) do { *(LAS f32x4*)(dst) = (f32x4){a[0], a[1], a[2], a[3]}; *(LAS f32x4*)((dst) + 4) = (f32x4){a[4], a[5], a[6], a[7]}; } while (0)
#define SCAN_COMMIT(cc_) do { LAS float* bb_ = bufs + ((cc_) & 1) * 5 * (TC * 64) + lrow * 64 + c8; \
        if (sel == 0) { const bool z_ = ((cc_) == 0 && lrow == 0); float pc[8], pp[8], rr[8], kr[8], av[8], kk[8], o[8]; \
            unpack8(q0, pc); unpack8(q1, pp); \
            _Pragma("unroll") for (int j = 0; j < 8; ++j) { const float pv = z_ ? 0.f : pp[j]; rr[j] = pc[j] + (pv - pc[j]) * m0[j]; } \
            ST8(bb_, rr); \
            unpack8(q2, pc); unpack8(q3, pp); unpack8(q4, av); unpack8(q5, kk); \
            float rks = 0.f; \
            _Pragma("unroll") for (int j = 0; j < 8; ++j) { const float pv = z_ ? 0.f : pp[j]; const float kx = pc[j] + (pv - pc[j]) * m1[j]; kr[j] = kx * (1.0f + (av[j] - 1.0f) * ka8[j]); o[j] = kk[j] * av[j]; rks += rr[j] * kr[j] * rk8[j]; } \
            ST8(bb_ + 2 * TC * 64, kr); ST8(bb_ + 3 * TC * 64, kk); ST8(bb_ + 4 * TC * 64, o); \
            rks = red8(rks); \
            if (half == 0 && (li & 7) == 0) RK[(tok0 + (size_t)(cc_) * TC + lrow) * 12 + h] = rks; \
        } else { float o[8]; \
            o[0] = __expf(h2f((unsigned short)(q0.x & 0xffffu))); o[1] = __expf(h2f((unsigned short)(q0.x >> 16))); o[2] = __expf(h2f((unsigned short)(q0.y & 0xffffu))); o[3] = __expf(h2f((unsigned short)(q0.y >> 16))); \
            o[4] = __expf(h2f((unsigned short)(q0.z & 0xffffu))); o[5] = __expf(h2f((unsigned short)(q0.z >> 16))); o[6] = __expf(h2f((unsigned short)(q0.w & 0xffffu))); o[7] = __expf(h2f((unsigned short)(q0.w >> 16))); \
            ST8(bb_ + 1 * TC * 64, o); \
            if (vthr) { const bool zv_ = ((cc_) == 0 && lrv == 0); float pc[8], pp[8]; unpack8(q1, pc); unpack8(q2, pp); \
                _Pragma("unroll") for (int j = 0; j < 8; ++j) { const float pv = zv_ ? 0.f : pp[j]; o[j] = pc[j] + (pv - pc[j]) * m0[j]; } \
                LAS float* vb_ = vbuf + ((cc_) & 1) * TC * 32 + lrv * 32 + (li & 3) * 8; ST8(vb_, o); } } } while (0)
    const int rg = lane >> 4, kl = lane & 15, row32 = wave * 4 + rg;
    f32x4 S = (f32x4){0.f, 0.f, 0.f, 0.f};
    SCAN_ISSUE(0); SCAN_COMMIT(0); __syncthreads();
    for (int chunk = 0; chunk < NCH; ++chunk) {
        if (chunk + 1 < NCH) SCAN_ISSUE(chunk + 1);
        const LAS float* bb = bufs + (chunk & 1) * 5 * TC * 64 + kl * 4;
        const LAS float* vb = vbuf + (chunk & 1) * TC * 32 + row32;
#define SCAN_LD(X, t) do { const LAS float* q_ = bb + (t) * 64; X.kk = *(const LAS f32x4*)(q_ + 3 * TC * 64); X.w = *(const LAS f32x4*)(q_ + 1 * TC * 64); X.ka = *(const LAS f32x4*)(q_ + 4 * TC * 64); \
            X.k = *(const LAS f32x4*)(q_ + 2 * TC * 64); X.r = *(const LAS f32x4*)(q_); X.v = vb[(t) * 32]; } while (0)
#define SCAN_STEP(X, yout) do { const f32x4 pa_ = S * X.kk; const f32x2 pq_ = pa_.xy + pa_.zw; float sa_ = pq_.x + pq_.y; sa_ = -red16(sa_); \
            S = S * X.w + (X.ka * sa_ + X.k * X.v); \
            const f32x4 py_ = S * X.r; const f32x2 pr_ = py_.xy + py_.zw; const float y_ = pr_.x + pr_.y; yout = red16(y_); } while (0)
        ScanOps X0, X1;
        SCAN_LD(X0, 0);
        for (int t = 0; t < TC; t += 2) {
            float y0, y1;
            SCAN_LD(X1, t + 1);
            SCAN_STEP(X0, y0);
            SCAN_LD(X0, t + 2);
            SCAN_STEP(X1, y1);
            if (kl == 0) { ys[t * 32 + row32] = y0; ys[(t + 1) * 32 + row32] = y1; }
        }
#undef SCAN_LD
#undef SCAN_STEP
        __syncthreads();
        {
            const int t = tid >> 4, r2 = (tid & 15) * 2;
            const f32x2 yv = *(const LAS f32x2*)(ys + t * 32 + r2);
            *(unsigned*)(Y + (tok0 + (size_t)chunk * TC + t) * D + h * 64 + 32 * half + r2) = cvtpk(yv[0], yv[1]);
        }
        if (chunk + 1 < NCH) SCAN_COMMIT(chunk + 1);
        __syncthreads();
    }
#undef SCAN_ISSUE
#undef SCAN_COMMIT
#undef ST8
}

constexpr int CH = 16, WINCH = 32, NWIN = (T / CH) / WINCH;
constexpr int CK_AT = 0, CK_RT = 2048, CK_KB = 4096, CK_VF = 8192, CK_G1 = 10240, CK_G2 = 10752, CK_G3 = 11264, CK_W = 12288, CK_BYTES = 12544;
constexpr int PREP_LDS = 14336;
struct PrepRaw { u32x4 q[2][9]; };
__device__ __forceinline__ void rwkv_prep_issue(PrepRaw& R, int hh, int c, const bf16_t* P, const unsigned short* WL, const bf16_t* AB, const bf16_t* KKb, int lane) {
    const int b = hh / 12, h = hh % 12; const size_t tok0 = (size_t)b * T + (size_t)c * CH; const int chn = h * 64 + (lane & 7) * 8;
#pragma unroll
    for (int i = 0; i < 2; ++i) { const int row = (lane >> 3) + 8 * i; const size_t tok = tok0 + row; const size_t tokp = (c == 0 && row == 0) ? tok : tok - 1;
        R.q[i][0] = *(const u32x4*)(P + tok * AIN + chn); R.q[i][1] = *(const u32x4*)(P + tokp * AIN + chn);
        R.q[i][2] = *(const u32x4*)(P + tok * AIN + RW + chn); R.q[i][3] = *(const u32x4*)(P + tokp * AIN + RW + chn);
        R.q[i][4] = *(const u32x4*)(P + tok * AIN + 1536 + chn); R.q[i][5] = *(const u32x4*)(P + tokp * AIN + 1536 + chn);
        R.q[i][6] = *(const u32x4*)(AB + tok * RW + chn); R.q[i][7] = *(const u32x4*)(KKb + tok * RW + chn); R.q[i][8] = *(const u32x4*)(WL + tok * RW + chn); }
}
__device__ __forceinline__ void rwkv_prep_compute(LAS unsigned char* L, int hh, int c, unsigned char* rec, PrepRaw& R, const bf16_t* P, const unsigned short* WL, const bf16_t* AB, const bf16_t* KKb,
                                                  const float* mu, const float* k_a, const float* r_k, float* RK, int lane, bool has_next, int hh_n, int c_n) {
    const int b = hh / 12, h = hh % 12; const size_t tok0 = (size_t)b * T + (size_t)c * CH;
    LAS float* Wf = (LAS float*)L;
    LAS bf16_t* tKK = (LAS bf16_t*)(L + 4096); LAS bf16_t* tR = (LAS bf16_t*)(L + 6144); LAS bf16_t* tKM = (LAS bf16_t*)(L + 8192); LAS bf16_t* tB = (LAS bf16_t*)(L + 10240); LAS bf16_t* tV = (LAS bf16_t*)(L + 12288);
    const int lr = lane & 15, Q = lane >> 4;
    {
        const int c8 = (lane & 7) * 8, chn = h * 64 + c8;
        float mr[8], mk[8], mv[8], ka8[8], rk8[8];
        *(f32x4*)mr = *(const f32x4*)(mu + chn); *(f32x4*)(mr + 4) = *(const f32x4*)(mu + chn + 4);
        *(f32x4*)mk = *(const f32x4*)(mu + RW + chn); *(f32x4*)(mk + 4) = *(const f32x4*)(mu + RW + chn + 4);
        *(f32x4*)mv = *(const f32x4*)(mu + 1536 + chn); *(f32x4*)(mv + 4) = *(const f32x4*)(mu + 1536 + chn + 4);
        *(f32x4*)ka8 = *(const f32x4*)(k_a + chn); *(f32x4*)(ka8 + 4) = *(const f32x4*)(k_a + chn + 4);
        *(f32x4*)rk8 = *(const f32x4*)(r_k + chn); *(f32x4*)(rk8 + 4) = *(const f32x4*)(r_k + chn + 4);
#pragma unroll
        for (int i = 0; i < 2; ++i) {
            const int row = (lane >> 3) + 8 * i; const size_t tok = tok0 + row; const bool z = (c == 0 && row == 0);
            const u32x4 qr = R.q[i][0], qrp = R.q[i][1], qk = R.q[i][2], qkp = R.q[i][3], qv = R.q[i][4], qvp = R.q[i][5], qa = R.q[i][6], qkk = R.q[i][7], qw = R.q[i][8];
            float pc[8], pp[8], rr[8], km[8], vv[8], av[8], kk[8], bb[8], ww[8];
            unpack8(qr, pc); unpack8(qrp, pp);
#pragma unroll
            for (int j = 0; j < 8; ++j) { const float pv = z ? 0.f : pp[j]; rr[j] = pc[j] + (pv - pc[j]) * mr[j]; }
            unpack8(qk, pc); unpack8(qkp, pp); unpack8(qa, av); unpack8(qkk, kk);
            float rks = 0.f;
#pragma unroll
            for (int j = 0; j < 8; ++j) { const float pv = z ? 0.f : pp[j]; const float kx = pc[j] + (pv - pc[j]) * mk[j]; km[j] = kx * (1.0f + (av[j] - 1.0f) * ka8[j]); bb[j] = kk[j] * av[j]; rks += rr[j] * km[j] * rk8[j]; }
            unpack8(qv, pc); unpack8(qvp, pp);
#pragma unroll
            for (int j = 0; j < 8; ++j) { const float pv = z ? 0.f : pp[j]; vv[j] = pc[j] + (pv - pc[j]) * mv[j]; }
            rks = red8(rks);
            if ((lane & 7) == 0) RK[tok * 12 + h] = rks;
            ww[0] = __expf(h2f((unsigned short)(qw.x & 0xffffu))); ww[1] = __expf(h2f((unsigned short)(qw.x >> 16))); ww[2] = __expf(h2f((unsigned short)(qw.y & 0xffffu))); ww[3] = __expf(h2f((unsigned short)(qw.y >> 16)));
            ww[4] = __expf(h2f((unsigned short)(qw.z & 0xffffu))); ww[5] = __expf(h2f((unsigned short)(qw.z >> 16))); ww[6] = __expf(h2f((unsigned short)(qw.w & 0xffffu))); ww[7] = __expf(h2f((unsigned short)(qw.w >> 16)));
            *(LAS f32x4*)(Wf + row * 64 + c8) = (f32x4){ww[0], ww[1], ww[2], ww[3]}; *(LAS f32x4*)(Wf + row * 64 + c8 + 4) = (f32x4){ww[4], ww[5], ww[6], ww[7]};
            *(LAS u32x4*)(tKK + row * 64 + c8) = pack8(kk); *(LAS u32x4*)(tR + row * 64 + c8) = pack8(rr); *(LAS u32x4*)(tKM + row * 64 + c8) = pack8(km);
            *(LAS u32x4*)(tB + row * 64 + c8) = pack8(bb); *(LAS u32x4*)(tV + row * 64 + c8) = pack8(vv);
        }
    }
    if (has_next) rwkv_prep_issue(R, hh_n, c_n, P, WL, AB, KKb, lane);
    asm volatile("s_waitcnt lgkmcnt(0)" ::: "memory");
    {
        const int cp = lane & 31, hf = lane >> 5;
        float wl0[8], wl1[8]; float a0 = 1.0f, a1 = 1.0f;
#pragma unroll
        for (int tt = 0; tt < 8; ++tt) { const f32x2 w2 = *(const LAS f32x2*)(Wf + (8 * hf + tt) * 64 + 2 * cp); a0 *= w2.x; a1 *= w2.y; wl0[tt] = a0; wl1[tt] = a1; }
        asm volatile("s_waitcnt lgkmcnt(0)" ::: "memory");
        if (hf == 0) *(LAS f32x2*)(Wf + 2 * cp) = (f32x2){a0, a1};
        asm volatile("s_waitcnt lgkmcnt(0)" ::: "memory");
        f32x2 bs = (f32x2){1.0f, 1.0f};
        if (hf == 1) bs = *(const LAS f32x2*)(Wf + 2 * cp);
        float kap0[8], kap1[8], bet0[8], bet1[8]; unsigned vraw[8];
#pragma unroll
        for (int tt = 0; tt < 8; ++tt) {
            const int t = 8 * hf + tt;
            const float W0 = bs.x * wl0[tt], W1 = bs.y * wl1[tt]; const float P0 = (tt == 0) ? bs.x : bs.x * wl0[tt > 0 ? tt - 1 : 0], P1 = (tt == 0) ? bs.y : bs.y * wl1[tt > 0 ? tt - 1 : 0];
            const float i0 = __builtin_amdgcn_rcpf(W0), i1 = __builtin_amdgcn_rcpf(W1);
            const unsigned qkk = *(const LAS unsigned*)(tKK + t * 64 + 2 * cp), qr = *(const LAS unsigned*)(tR + t * 64 + 2 * cp), qkm = *(const LAS unsigned*)(tKM + t * 64 + 2 * cp), qb = *(const LAS unsigned*)(tB + t * 64 + 2 * cp);
            vraw[tt] = *(const LAS unsigned*)(tV + t * 64 + 2 * cp);
            kap0[tt] = bflo(qkm) * i0; kap1[tt] = bfhi(qkm) * i1; bet0[tt] = bflo(qb) * i0; bet1[tt] = bfhi(qb) * i1;
            *(LAS unsigned*)(tKK + t * 64 + 2 * cp) = cvtpk(P0 * bflo(qkk), P1 * bfhi(qkk)); *(LAS unsigned*)(tR + t * 64 + 2 * cp) = cvtpk(W0 * bflo(qr), W1 * bfhi(qr));
            *(LAS unsigned*)(tKM + t * 64 + 2 * cp) = cvtpk(kap0[tt], kap1[tt]); *(LAS unsigned*)(tB + t * 64 + 2 * cp) = cvtpk(bet0[tt], bet1[tt]);
        }
        u32x4* kbp = (u32x4*)(rec + CK_KB); u32x2* vfp = (u32x2*)(rec + CK_VF);
        const int k0 = 2 * cp, kt0 = k0 >> 4, r0 = k0 & 15;
#pragma unroll
        for (int q = 0; q < 2; ++q) { const int Qp = 2 * hf + q;
            u32x4 wa; wa.x = cvtpk(kap0[4 * q], kap0[4 * q + 1]); wa.y = cvtpk(kap0[4 * q + 2], kap0[4 * q + 3]); wa.z = cvtpk(-bet0[4 * q], -bet0[4 * q + 1]); wa.w = cvtpk(-bet0[4 * q + 2], -bet0[4 * q + 3]);
            u32x4 wb; wb.x = cvtpk(kap1[4 * q], kap1[4 * q + 1]); wb.y = cvtpk(kap1[4 * q + 2], kap1[4 * q + 3]); wb.z = cvtpk(-bet1[4 * q], -bet1[4 * q + 1]); wb.w = cvtpk(-bet1[4 * q + 2], -bet1[4 * q + 3]);
            kbp[(kt0 * 4 + Qp) * 16 + r0] = wa; kbp[(kt0 * 4 + Qp) * 16 + r0 + 1] = wb;
            u32x2 va; va.x = (vraw[4 * q] & 0xffffu) | (vraw[4 * q + 1] << 16); va.y = (vraw[4 * q + 2] & 0xffffu) | (vraw[4 * q + 3] << 16);
            u32x2 vb; vb.x = (vraw[4 * q] >> 16) | (vraw[4 * q + 1] & 0xffff0000u); vb.y = (vraw[4 * q + 2] >> 16) | (vraw[4 * q + 3] & 0xffff0000u);
            vfp[(kt0 * 4 + Qp) * 16 + r0] = va; vfp[(kt0 * 4 + Qp) * 16 + r0 + 1] = vb; }
        if (hf == 1) *(f32x2*)((float*)(rec + CK_W) + 2 * cp) = (f32x2){bs.x * wl0[7], bs.y * wl1[7]};
    }
    asm volatile("s_waitcnt lgkmcnt(0)" ::: "memory");
    {
        bf16x8 aB[2], aK[2], bA[2], bR[2];
#pragma unroll
        for (int p = 0; p < 2; ++p) { const int o = lr * 64 + 32 * p + 8 * Q;
            aB[p] = *(const LAS bf16x8*)(tB + o); aK[p] = *(const LAS bf16x8*)(tKM + o); bA[p] = *(const LAS bf16x8*)(tKK + o); bR[p] = *(const LAS bf16x8*)(tR + o); }
        const f32x4 z4 = (f32x4){0.f, 0.f, 0.f, 0.f};
        f32x4 Nb = __builtin_amdgcn_mfma_f32_16x16x32_bf16(aB[0], bA[0], z4, 0, 0, 0); Nb = __builtin_amdgcn_mfma_f32_16x16x32_bf16(aB[1], bA[1], Nb, 0, 0, 0);
        f32x4 Nk = __builtin_amdgcn_mfma_f32_16x16x32_bf16(aK[0], bA[0], z4, 0, 0, 0); Nk = __builtin_amdgcn_mfma_f32_16x16x32_bf16(aK[1], bA[1], Nk, 0, 0, 0);
        f32x4 Mk = __builtin_amdgcn_mfma_f32_16x16x32_bf16(aK[0], bR[0], z4, 0, 0, 0); Mk = __builtin_amdgcn_mfma_f32_16x16x32_bf16(aK[1], bR[1], Mk, 0, 0, 0);
        f32x4 Mb = __builtin_amdgcn_mfma_f32_16x16x32_bf16(aB[0], bR[0], z4, 0, 0, 0); Mb = __builtin_amdgcn_mfma_f32_16x16x32_bf16(aB[1], bR[1], Mb, 0, 0, 0);
#pragma unroll
        for (int r = 0; r < 4; ++r) { const int j = 4 * Q + r; if (!(j < lr)) { Nb[r] = 0.f; Nk[r] = 0.f; } if (!(j <= lr)) { Mk[r] = 0.f; Mb[r] = 0.f; } }
        u32x2 g1; g1.x = cvtpk(Nk[0], Nk[1]); g1.y = cvtpk(Nk[2], Nk[3]); ((u32x2*)(rec + CK_G1))[lane] = g1;
        u32x4 g3; g3.x = cvtpk(Mk[0], Mk[1]); g3.y = cvtpk(Mk[2], Mk[3]); g3.z = cvtpk(-Mb[0], -Mb[1]); g3.w = cvtpk(-Mb[2], -Mb[3]); ((u32x4*)(rec + CK_G3))[lane] = g3;
        *(LAS f32x4*)(Wf + lr * 16 + 4 * Q) = Nb;
    }
    asm volatile("s_waitcnt lgkmcnt(0)" ::: "memory");
    {
        float Tr[16];
#pragma unroll
        for (int t = 0; t < 16; ++t) {
            const f32x4 zz = (f32x4){0.f, 0.f, 0.f, 0.f};
            const f32x4 n0 = (t > 0) ? *(const LAS f32x4*)(Wf + t * 16) : zz, n1 = (t > 4) ? *(const LAS f32x4*)(Wf + t * 16 + 4) : zz, n2 = (t > 8) ? *(const LAS f32x4*)(Wf + t * 16 + 8) : zz, n3 = (t > 12) ? *(const LAS f32x4*)(Wf + t * 16 + 12) : zz;
            const float nt[16] = {n0[0], n0[1], n0[2], n0[3], n1[0], n1[1], n1[2], n1[3], n2[0], n2[1], n2[2], n2[3], n3[0], n3[1], n3[2], n3[3]};
            float sacc = (t == lr) ? 1.0f : 0.0f;
#pragma unroll
            for (int m = 0; m < t; ++m) sacc -= Tr[m] * nt[m];
            Tr[t] = sacc;
        }
        if (Q == 0) {
#pragma unroll
            for (int q = 0; q < 4; ++q) *(LAS f32x4*)(Wf + 256 + lr * 16 + 4 * q) = (f32x4){Tr[4 * q], Tr[4 * q + 1], Tr[4 * q + 2], Tr[4 * q + 3]}; }
    }
    asm volatile("s_waitcnt lgkmcnt(0)" ::: "memory");
    {
        u32x2 g2; g2.x = cvtpk(Wf[256 + (4 * Q) * 16 + lr], Wf[256 + (4 * Q + 1) * 16 + lr]); g2.y = cvtpk(Wf[256 + (4 * Q + 2) * 16 + lr], Wf[256 + (4 * Q + 3) * 16 + lr]);
        ((u32x2*)(rec + CK_G2))[lane] = g2;
#pragma unroll
        for (int p = 0; p < 2; ++p) { const int o = lr * 64 + 32 * p + 4 * Q;
            const u32x2 alo = *(const LAS u32x2*)(tKK + o), ahi = *(const LAS u32x2*)(tKK + o + 16), rlo = *(const LAS u32x2*)(tR + o), rhi = *(const LAS u32x2*)(tR + o + 16);
            ((u32x4*)(rec + CK_AT))[p * 64 + lane] = (u32x4){alo.x, alo.y, ahi.x, ahi.y}; ((u32x4*)(rec + CK_RT))[p * 64 + lane] = (u32x4){rlo.x, rlo.y, rhi.x, rhi.y}; }
    }
    asm volatile("s_waitcnt lgkmcnt(0)" ::: "memory");
}
__device__ __forceinline__ void rwkv_prep_chunk(LAS unsigned char* L, int hh, int c, unsigned char* rec, const bf16_t* P, const unsigned short* WL, const bf16_t* AB, const bf16_t* KKb,
                                                const float* mu, const float* k_a, const float* r_k, float* RK, int lane) {
    PrepRaw R; rwkv_prep_issue(R, hh, c, P, WL, AB, KKb, lane);
    rwkv_prep_compute(L, hh, c, rec, R, P, WL, AB, KKb, mu, k_a, r_k, RK, lane, false, 0, 0);
}
template <int CTRL> __device__ __forceinline__ float dpp_keep(float old, float x) { return __int_as_float(__builtin_amdgcn_update_dpp(__float_as_int(old), __float_as_int(x), CTRL, 0xf, 0xf, false)); }
__device__ __forceinline__ void rwkv_prep2(LAS unsigned char* L, int hh, int c, unsigned char* rec, const bf16_t* P, const unsigned short* WL, const bf16_t* AB, const float* k_k,
                                           const float* mu, const float* k_a, const float* r_k, float* RK, int lane_) {
    int lane = lane_; asm volatile("" : "+v"(lane));
    const int b = hh / 12, h = hh % 12; const size_t tok0 = (size_t)b * T + (size_t)c * CH;
    LAS float* Wf = (LAS float*)L;
    const int t = lane & 15, cg = lane >> 4, lr = t, Q = cg;
    const int chn = h * 64 + 16 * cg; const size_t tok = tok0 + t;
    bf16x8 bA[2], bR[2], aK[2], aB[2], aV[2];
    float rks = 0.f;
    const bool first = (c == 0);
    float kxs[16]; float knorm;
    { float ss = 0.f;
#pragma unroll
      for (int hf = 0; hf < 2; ++hf) { const int ch = chn + 8 * hf; const unsigned po_ = (unsigned)tok * (unsigned)AIN + (unsigned)ch;
          const u32x4 qk = *(const u32x4*)(P + (po_ + RW)); u32x4 pk_ = (u32x4){0u, 0u, 0u, 0u}; if (t == 0 && !first) pk_ = *(const u32x4*)(P + (po_ - AIN + RW));
          float pc[8], po[8], m8[8], q8[8]; unpack8(qk, pc); unpack8(pk_, po);
          *(f32x4*)m8 = *(const f32x4*)(mu + RW + ch); *(f32x4*)(m8 + 4) = *(const f32x4*)(mu + RW + ch + 4); *(f32x4*)q8 = *(const f32x4*)(k_k + ch); *(f32x4*)(q8 + 4) = *(const f32x4*)(k_k + ch + 4);
#pragma unroll
          for (int j = 0; j < 8; ++j) { const float pv = dpp_keep<0x111>(po[j], pc[j]); const float kx = pc[j] + (pv - pc[j]) * m8[j]; kxs[8 * hf + j] = kx; const float kq = kx * q8[j]; ss += kq * kq; } }
      ss += __shfl_xor(ss, 16); ss += __shfl_xor(ss, 32);
      knorm = 1.0f / fmaxf(sqrtf(ss), 1e-12f); }
#pragma unroll
    for (int hf = 0; hf < 2; ++hf) {
        const int ch = chn + 8 * hf;
        const unsigned po_ = (unsigned)tok * (unsigned)AIN + (unsigned)ch, so_ = (unsigned)tok * (unsigned)RW + (unsigned)ch;
        const u32x4 qr = *(const u32x4*)(P + po_), qv = *(const u32x4*)(P + (po_ + 1536));
        const u32x4 qa = *(const u32x4*)(AB + so_), qw = *(const u32x4*)(WL + so_);
        u32x4 pr_ = (u32x4){0u, 0u, 0u, 0u}, pv_ = pr_;
        if (t == 0 && !first) { pr_ = *(const u32x4*)(P + (po_ - AIN)); pv_ = *(const u32x4*)(P + (po_ - AIN + 1536)); }
        float pc[8], po[8], av[8], rr[8], km[8], bb[8], kk[8], W[8], m8[8], g8[8];
        unpack8(qr, pc); unpack8(pr_, po); *(f32x4*)m8 = *(const f32x4*)(mu + ch); *(f32x4*)(m8 + 4) = *(const f32x4*)(mu + ch + 4);
#pragma unroll
        for (int j = 0; j < 8; ++j) { const float pv = dpp_keep<0x111>(po[j], pc[j]); rr[j] = pc[j] + (pv - pc[j]) * m8[j]; }
        unpack8(qa, av);
        *(f32x4*)m8 = *(const f32x4*)(k_k + ch); *(f32x4*)(m8 + 4) = *(const f32x4*)(k_k + ch + 4); *(f32x4*)g8 = *(const f32x4*)(k_a + ch); *(f32x4*)(g8 + 4) = *(const f32x4*)(k_a + ch + 4);
#pragma unroll
        for (int j = 0; j < 8; ++j) { const float kx = kxs[8 * hf + j]; kk[j] = kx * m8[j] * knorm;
            km[j] = kx * (1.0f + (av[j] - 1.0f) * g8[j]); bb[j] = kk[j] * av[j]; }
        *(f32x4*)g8 = *(const f32x4*)(r_k + ch); *(f32x4*)(g8 + 4) = *(const f32x4*)(r_k + ch + 4);
#pragma unroll
        for (int j = 0; j < 8; ++j) rks += rr[j] * km[j] * g8[j];
        unpack8(qv, pc); unpack8(pv_, po); *(f32x4*)m8 = *(const f32x4*)(mu + 1536 + ch); *(f32x4*)(m8 + 4) = *(const f32x4*)(mu + 1536 + ch + 4);
#pragma unroll
        for (int j = 0; j < 8; ++j) { const float pv = dpp_keep<0x111>(po[j], pc[j]); po[j] = pc[j] + (pv - pc[j]) * m8[j]; }
        aV[hf] = __builtin_bit_cast(bf16x8, pack8(po));
        W[0] = __expf(h2f((unsigned short)(qw.x & 0xffffu))); W[1] = __expf(h2f((unsigned short)(qw.x >> 16))); W[2] = __expf(h2f((unsigned short)(qw.y & 0xffffu))); W[3] = __expf(h2f((unsigned short)(qw.y >> 16)));
        W[4] = __expf(h2f((unsigned short)(qw.z & 0xffffu))); W[5] = __expf(h2f((unsigned short)(qw.z >> 16))); W[6] = __expf(h2f((unsigned short)(qw.w & 0xffffu))); W[7] = __expf(h2f((unsigned short)(qw.w >> 16)));
#pragma unroll
        for (int i = 0; i < 8; ++i) { float w = W[i];
            w *= dpp_keep<0x111>(1.0f, w); w *= dpp_keep<0x112>(1.0f, w); w *= dpp_keep<0x114>(1.0f, w); w *= dpp_keep<0x118>(1.0f, w);
            const float wp = dpp_keep<0x111>(1.0f, w); const float iw = __builtin_amdgcn_rcpf(w);
            W[i] = w; kk[i] *= wp; rr[i] *= w; km[i] *= iw; bb[i] *= iw; }
        bA[hf] = __builtin_bit_cast(bf16x8, pack8(kk)); bR[hf] = __builtin_bit_cast(bf16x8, pack8(rr)); aK[hf] = __builtin_bit_cast(bf16x8, pack8(km)); aB[hf] = __builtin_bit_cast(bf16x8, pack8(bb));
        if (t == 15) { *(f32x4*)((float*)(rec + CK_W) + 16 * (2 * hf) + 4 * cg) = (f32x4){W[0], W[1], W[2], W[3]}; *(f32x4*)((float*)(rec + CK_W) + 16 * (2 * hf + 1) + 4 * cg) = (f32x4){W[4], W[5], W[6], W[7]}; }
        asm volatile("" : "+v"(bA[hf]), "+v"(bR[hf]), "+v"(aK[hf]), "+v"(aB[hf]), "+v"(aV[hf]) : : "memory");
    }
    rks += __shfl_xor(rks, 16); rks += __shfl_xor(rks, 32);
    if (cg == 0) RK[tok * 12 + h] = rks;
    const f32x4 z4 = (f32x4){0.f, 0.f, 0.f, 0.f};
#pragma unroll
    for (int p = 0; p < 2; ++p) { ((u32x4*)(rec + CK_AT))[p * 64 + lane] = __builtin_bit_cast(u32x4, bA[p]); ((u32x4*)(rec + CK_RT))[p * 64 + lane] = __builtin_bit_cast(u32x4, bR[p]); }
    {
        const unsigned one = 0x3F80u; const bool on = (Q == (lr >> 2));
#pragma unroll
        for (int e = 0; e < 2; ++e) { const int slot = 4 * e + (lr & 3); const unsigned val = on ? (one << (16 * (slot & 1))) : 0u; const int wd = slot >> 1;
            const u32x4 selw = (u32x4){wd == 0 ? val : 0u, wd == 1 ? val : 0u, wd == 2 ? val : 0u, wd == 3 ? val : 0u}; const bf16x8 sel = __builtin_bit_cast(bf16x8, selw);
#pragma unroll
            for (int p = 0; p < 2; ++p) { const f32x4 Dk = __builtin_amdgcn_mfma_f32_16x16x32_bf16(aK[p], sel, z4, 0, 0, 0), Db = __builtin_amdgcn_mfma_f32_16x16x32_bf16(aB[p], sel, z4, 0, 0, 0);
                u32x4 w; w.x = cvtpk(Dk[0], Dk[1]); w.y = cvtpk(Dk[2], Dk[3]); w.z = cvtpk(-Db[0], -Db[1]); w.w = cvtpk(-Db[2], -Db[3]);
                ((u32x4*)(rec + CK_KB))[(2 * p + e) * 64 + lane] = w; } }
#pragma unroll
        for (int vt = 0; vt < 4; ++vt) { f32x4 Dv = z4;
#pragma unroll
            for (int p = 0; p < 2; ++p) { const bool onv = (Q == vt) && ((lr >> 3) == p); const int slot = lr & 7; const unsigned val = onv ? (one << (16 * (slot & 1))) : 0u; const int wd = slot >> 1;
                const u32x4 selw = (u32x4){wd == 0 ? val : 0u, wd == 1 ? val : 0u, wd == 2 ? val : 0u, wd == 3 ? val : 0u};
                Dv = __builtin_amdgcn_mfma_f32_16x16x32_bf16(aV[p], __builtin_bit_cast(bf16x8, selw), Dv, 0, 0, 0); }
            u32x2 w; w.x = cvtpk(Dv[0], Dv[1]); w.y = cvtpk(Dv[2], Dv[3]); ((u32x2*)(rec + CK_VF))[vt * 64 + lane] = w; }
    }
    {
        f32x4 Nb = __builtin_amdgcn_mfma_f32_16x16x32_bf16(aB[0], bA[0], z4, 0, 0, 0); Nb = __builtin_amdgcn_mfma_f32_16x16x32_bf16(aB[1], bA[1], Nb, 0, 0, 0);
        f32x4 Nk = __builtin_amdgcn_mfma_f32_16x16x32_bf16(aK[0], bA[0], z4, 0, 0, 0); Nk = __builtin_amdgcn_mfma_f32_16x16x32_bf16(aK[1], bA[1], Nk, 0, 0, 0);
        f32x4 Mk = __builtin_amdgcn_mfma_f32_16x16x32_bf16(aK[0], bR[0], z4, 0, 0, 0); Mk = __builtin_amdgcn_mfma_f32_16x16x32_bf16(aK[1], bR[1], Mk, 0, 0, 0);
        f32x4 Mb = __builtin_amdgcn_mfma_f32_16x16x32_bf16(aB[0], bR[0], z4, 0, 0, 0); Mb = __builtin_amdgcn_mfma_f32_16x16x32_bf16(aB[1], bR[1], Mb, 0, 0, 0);
#pragma unroll
        for (int r = 0; r < 4; ++r) { const int j = 4 * Q + r; if (!(j < lr)) { Nb[r] = 0.f; Nk[r] = 0.f; } if (!(j <= lr)) { Mk[r] = 0.f; Mb[r] = 0.f; } }
        u32x2 g1; g1.x = cvtpk(Nk[0], Nk[1]); g1.y = cvtpk(Nk[2], Nk[3]); ((u32x2*)(rec + CK_G1))[lane] = g1;
        u32x4 g3; g3.x = cvtpk(Mk[0], Mk[1]); g3.y = cvtpk(Mk[2], Mk[3]); g3.z = cvtpk(-Mb[0], -Mb[1]); g3.w = cvtpk(-Mb[2], -Mb[3]); ((u32x4*)(rec + CK_G3))[lane] = g3;
        *(LAS f32x4*)(Wf + lr * 16 + 4 * Q) = Nb;
    }
    asm volatile("s_waitcnt lgkmcnt(0)" ::: "memory");
    {
        float Tr[16];
#pragma unroll
        for (int tt = 0; tt < 16; ++tt) {
            const f32x4 zz = (f32x4){0.f, 0.f, 0.f, 0.f};
            const f32x4 n0 = (tt > 0) ? *(const LAS f32x4*)(Wf + tt * 16) : zz, n1 = (tt > 4) ? *(const LAS f32x4*)(Wf + tt * 16 + 4) : zz, n2 = (tt > 8) ? *(const LAS f32x4*)(Wf + tt * 16 + 8) : zz, n3 = (tt > 12) ? *(const LAS f32x4*)(Wf + tt * 16 + 12) : zz;
            const float nt[16] = {n0[0], n0[1], n0[2], n0[3], n1[0], n1[1], n1[2], n1[3], n2[0], n2[1], n2[2], n2[3], n3[0], n3[1], n3[2], n3[3]};
            float sacc = (tt == lr) ? 1.0f : 0.0f;
#pragma unroll
            for (int m = 0; m < tt; ++m) sacc -= Tr[m] * nt[m];
            Tr[tt] = sacc;
        }
        if (Q == 0) {
#pragma unroll
            for (int q = 0; q < 4; ++q) *(LAS f32x4*)(Wf + 256 + lr * 16 + 4 * q) = (f32x4){Tr[4 * q], Tr[4 * q + 1], Tr[4 * q + 2], Tr[4 * q + 3]}; }
    }
    asm volatile("s_waitcnt lgkmcnt(0)" ::: "memory");
    { u32x2 g2; g2.x = cvtpk(Wf[256 + (4 * Q) * 16 + lr], Wf[256 + (4 * Q + 1) * 16 + lr]); g2.y = cvtpk(Wf[256 + (4 * Q + 2) * 16 + lr], Wf[256 + (4 * Q + 3) * 16 + lr]);
      ((u32x2*)(rec + CK_G2))[lane] = g2; }
    asm volatile("s_waitcnt lgkmcnt(0)" ::: "memory");
}
struct ChunkRec { u32x4 at0, at1, rt0, rt1, kb0, kb1, kb2, kb3, g3; u32x2 vf, g1, g2; f32x4 w0, w1, w2, w3; };
constexpr int RING_SLOTS = 8, RING_DIST = 6;
__device__ __forceinline__ void rwkv_seq_window(LAS unsigned char* lds, int hh, int win, const unsigned char* CKBw, float* SBUF, bf16_t* Y, int tid) {
    const int wave = __builtin_amdgcn_readfirstlane(tid >> 6), lane = tid & 63;
    const unsigned char* rec0 = CKBw + (size_t)hh * WINCH * CK_BYTES;
    if (wave >= 4) {
        const int lw = wave - 4;
#define RING_ISSUE(chunk_) do { const unsigned char* g_ = rec0 + (size_t)(chunk_) * CK_BYTES + lane * 16; LAS unsigned char* d_ = lds + ((chunk_) & (RING_SLOTS - 1)) * CK_BYTES; \
            __builtin_amdgcn_global_load_lds((const unsigned*)(g_ + lw * 1024), (LAS unsigned*)(d_ + lw * 1024), 16, 0, 0); \
            __builtin_amdgcn_global_load_lds((const unsigned*)(g_ + (lw + 4) * 1024), (LAS unsigned*)(d_ + (lw + 4) * 1024), 16, 0, 0); \
            __builtin_amdgcn_global_load_lds((const unsigned*)(g_ + (lw + 8) * 1024), (LAS unsigned*)(d_ + (lw + 8) * 1024), 16, 0, 0); \
            if (lw == 0 && lane < 16) __builtin_amdgcn_global_load_lds((const unsigned*)(g_ + 12288), (LAS unsigned*)(d_ + 12288), 16, 0, 0); } while (0)
#pragma unroll
        for (int c = 0; c < RING_DIST; ++c) RING_ISSUE(c);
        asm volatile("s_waitcnt vmcnt(12)" ::: "memory");
        __builtin_amdgcn_s_barrier();
        for (int c = 0; c < WINCH; ++c) {
            if (c + RING_DIST < WINCH) { RING_ISSUE(c + RING_DIST); asm volatile("s_waitcnt vmcnt(12)" ::: "memory"); }
            else asm volatile("s_waitcnt vmcnt(0)" ::: "memory");
            __builtin_amdgcn_s_barrier();
        }
#undef RING_ISSUE
        return;
    }
    const int vt = wave, lr = lane & 15, Q = lane >> 4, b = hh / 12, h = hh % 12;
    f32x4 S0, S1, S2, S3;
    f32x4* sb = (f32x4*)SBUF + ((size_t)(hh * 4 + vt) * 4) * 64 + lane;
    if (win == 0) { S0 = S1 = S2 = S3 = (f32x4){0.f, 0.f, 0.f, 0.f}; } else { S0 = sb[0]; S1 = sb[64]; S2 = sb[128]; S3 = sb[192]; }
#define CK_LOAD(R, chunk_) do { const LAS unsigned char* q_ = lds + ((chunk_) & (RING_SLOTS - 1)) * CK_BYTES; R.at0 = ((const LAS u32x4*)(q_ + CK_AT))[lane]; R.at1 = ((const LAS u32x4*)(q_ + CK_AT))[64 + lane]; R.rt0 = ((const LAS u32x4*)(q_ + CK_RT))[lane]; R.rt1 = ((const LAS u32x4*)(q_ + CK_RT))[64 + lane]; \
        R.kb0 = ((const LAS u32x4*)(q_ + CK_KB))[lane]; R.kb1 = ((const LAS u32x4*)(q_ + CK_KB))[64 + lane]; R.kb2 = ((const LAS u32x4*)(q_ + CK_KB))[128 + lane]; R.kb3 = ((const LAS u32x4*)(q_ + CK_KB))[192 + lane]; \
        R.g3 = ((const LAS u32x4*)(q_ + CK_G3))[lane]; R.vf = ((const LAS u32x2*)(q_ + CK_VF))[vt * 64 + lane]; R.g1 = ((const LAS u32x2*)(q_ + CK_G1))[lane]; R.g2 = ((const LAS u32x2*)(q_ + CK_G2))[lane]; \
        const LAS float* w_ = (const LAS float*)(q_ + CK_W) + 4 * Q; R.w0 = *(const LAS f32x4*)(w_); R.w1 = *(const LAS f32x4*)(w_ + 16); R.w2 = *(const LAS f32x4*)(w_ + 32); R.w3 = *(const LAS f32x4*)(w_ + 48); } while (0)
#define BF8(x) __builtin_bit_cast(bf16x8, (x))
#define CK_STEP(R, cw_) do { const f32x4 z4 = (f32x4){0.f, 0.f, 0.f, 0.f}; \
        const u32x4 bS0 = (u32x4){cvtpk(S0[0], S0[1]), cvtpk(S0[2], S0[3]), cvtpk(S1[0], S1[1]), cvtpk(S1[2], S1[3])}, bS1 = (u32x4){cvtpk(S2[0], S2[1]), cvtpk(S2[2], S2[3]), cvtpk(S3[0], S3[1]), cvtpk(S3[2], S3[3])}; \
        f32x4 Z = __builtin_amdgcn_mfma_f32_16x16x32_bf16(BF8(((u32x4){R.g1.x, R.g1.y, 0u, 0u})), BF8(((u32x4){R.vf.x, R.vf.y, 0u, 0u})), z4, 0, 0, 0); \
        Z = __builtin_amdgcn_mfma_f32_16x16x32_bf16(BF8(R.at0), BF8(bS0), Z, 0, 0, 0); Z = __builtin_amdgcn_mfma_f32_16x16x32_bf16(BF8(R.at1), BF8(bS1), Z, 0, 0, 0); \
        f32x4 Yt = __builtin_amdgcn_mfma_f32_16x16x32_bf16(BF8(R.rt0), BF8(bS0), z4, 0, 0, 0); Yt = __builtin_amdgcn_mfma_f32_16x16x32_bf16(BF8(R.rt1), BF8(bS1), Yt, 0, 0, 0); \
        const f32x4 Dm = __builtin_amdgcn_mfma_f32_16x16x32_bf16(BF8(((u32x4){R.g2.x, R.g2.y, 0u, 0u})), BF8(((u32x4){cvtpk(Z[0], Z[1]), cvtpk(Z[2], Z[3]), 0u, 0u})), z4, 0, 0, 0); \
        const u32x4 bVD = (u32x4){R.vf.x, R.vf.y, cvtpk(Dm[0], Dm[1]), cvtpk(Dm[2], Dm[3])}; \
        Yt = __builtin_amdgcn_mfma_f32_16x16x32_bf16(BF8(R.g3), BF8(bVD), Yt, 0, 0, 0); \
        S0 = __builtin_amdgcn_mfma_f32_16x16x32_bf16(BF8(R.kb0), BF8(bVD), S0, 0, 0, 0) * R.w0; S1 = __builtin_amdgcn_mfma_f32_16x16x32_bf16(BF8(R.kb1), BF8(bVD), S1, 0, 0, 0) * R.w1; \
        S2 = __builtin_amdgcn_mfma_f32_16x16x32_bf16(BF8(R.kb2), BF8(bVD), S2, 0, 0, 0) * R.w2; S3 = __builtin_amdgcn_mfma_f32_16x16x32_bf16(BF8(R.kb3), BF8(bVD), S3, 0, 0, 0) * R.w3; \
        bf16_t* yp_ = Y + ((size_t)b * T + (size_t)(win * WINCH + (cw_)) * CH + 4 * Q) * D + h * 64 + 16 * vt + lr; \
        yp_[0] = f2bf(Yt[0]); yp_[D] = f2bf(Yt[1]); yp_[2 * D] = f2bf(Yt[2]); yp_[3 * D] = f2bf(Yt[3]); } while (0)
    ChunkRec RA, RB;
    __builtin_amdgcn_s_barrier();
    CK_LOAD(RA, 0);
    for (int cw = 0; cw < WINCH; cw += 2) {
        CK_LOAD(RB, cw + 1);
        CK_STEP(RA, cw);
        asm volatile("s_waitcnt lgkmcnt(0)" ::: "memory");
        __builtin_amdgcn_s_barrier();
        if (cw + 2 < WINCH) CK_LOAD(RA, cw + 2);
        CK_STEP(RB, cw + 1);
        asm volatile("s_waitcnt lgkmcnt(0)" ::: "memory");
        __builtin_amdgcn_s_barrier();
    }
#undef CK_LOAD
#undef CK_STEP
#undef BF8
    sb[0] = S0; sb[64] = S1; sb[128] = S2; sb[192] = S3;
}

#define XB_TMO      128
#define XB_XCNT(j)  (256  + 64 * (j))
#define XB_XSUB(j)  (1280 + 64 * (j))
#define XB_XGEN(j)  (2304 + 64 * (j))
#define XB_TOP      3328
#define XB_TOPGEN   3392
#define XCD_BAR_WORDS 3456
#define XB_SPIN_CAP (1u << 22)
__device__ __forceinline__ unsigned xb_ld(unsigned* p)              { return __hip_atomic_load(p, __ATOMIC_RELAXED, __HIP_MEMORY_SCOPE_AGENT); }
__device__ __forceinline__ unsigned xb_add(unsigned* p, unsigned v) { return __hip_atomic_fetch_add(p, v, __ATOMIC_RELAXED, __HIP_MEMORY_SCOPE_AGENT); }
__device__ __forceinline__ unsigned xb_xcc_id() { return (unsigned)__builtin_amdgcn_s_getreg((3 << 11) | 20) & 0xFu; }
#define XB_SPIN(cond, bar) do { unsigned _sp = 0; while (cond) { __builtin_amdgcn_s_sleep(1); \
    if ((++_sp & 255u) == 0u) { if (xb_ld(&(bar)[XB_TMO])) break; if (_sp > XB_SPIN_CAP) { atomicAdd(&(bar)[XB_TMO], 1u); break; } } } } while (0)
struct XcdBarrier { unsigned* bar; unsigned x; volatile LAS unsigned* st; };
__device__ __forceinline__ XcdBarrier xcd_barrier_post(unsigned* bar, volatile LAS unsigned* st) {
    XcdBarrier b; b.bar = bar; b.x = xb_xcc_id(); b.st = st;
    if (threadIdx.x == 0) (void)xb_add(&bar[XB_XCNT(b.x)], 1u);
    return b;
}
__device__ __forceinline__ void xcd_barrier_complete(unsigned* bar, unsigned x, unsigned& nloc, unsigned& nx) {
    const unsigned G = gridDim.x * gridDim.y * gridDim.z;
    unsigned sum, cnt, mine, sp = 0u;
    for (;;) {
        sum = 0u; cnt = 0u; mine = 0u;
#pragma unroll
        for (unsigned j = 0; j < 16; ++j) { const unsigned c = xb_ld(&bar[XB_XCNT(j)]); sum += c; cnt += (c > 0u) ? 1u : 0u; mine = (j == x) ? c : mine; }
        if (sum == G) break;
        __builtin_amdgcn_s_sleep(1);
        if ((++sp & 255u) == 0u) { if (xb_ld(&bar[XB_TMO])) break; if (sp > XB_SPIN_CAP) { atomicAdd(&bar[XB_TMO], 1u); break; } }
    }
    nloc = mine > 0u ? mine : 1u; nx = cnt > 0u ? cnt : 1u;
}
__device__ __forceinline__ void xcd_barrier(const XcdBarrier& b) {
    asm volatile("s_waitcnt vmcnt(0)" ::: "memory");
    __syncthreads();
    if (threadIdx.x == 0) {
        unsigned* bar = b.bar;
        __builtin_amdgcn_s_waitcnt(0);
        unsigned nloc = b.st[0], nx = b.st[1];
        if (nloc == 0u) { xcd_barrier_complete(bar, b.x, nloc, nx); b.st[0] = nloc; b.st[1] = nx; }
        const unsigned old = xb_add(&bar[XB_XSUB(b.x)], 1u);
        const unsigned gen = old / nloc;
        if (old + 1u == (gen + 1u) * nloc) {
            __builtin_amdgcn_fence(__ATOMIC_RELEASE, "agent");
            asm volatile("s_waitcnt vmcnt(0)" ::: "memory");
            const unsigned og = xb_add(&bar[XB_TOP], 1u);
            const unsigned tg = og / nx;
            if (og + 1u == (tg + 1u) * nx) xb_add(&bar[XB_TOPGEN], 1u);
            else XB_SPIN(xb_ld(&bar[XB_TOPGEN]) == tg, bar);
            __builtin_amdgcn_fence(__ATOMIC_ACQUIRE, "agent");
            xb_add(&bar[XB_XGEN(b.x)], 1u);
            asm volatile("s_waitcnt vmcnt(0)" ::: "memory");
        } else {
            XB_SPIN(xb_ld(&bar[XB_XGEN(b.x)]) == gen, bar);
            __builtin_amdgcn_fence(__ATOMIC_ACQUIRE, "agent");
            asm volatile("s_waitcnt vmcnt(0)" ::: "memory");
        }
    }
    __syncthreads();
}

__device__ __forceinline__ void fixup_panel(int tid, int pm, const float* cw, const float* cb, const float* HU, bf16_t* Z) {
    for (int i = tid; i < 4 * (FF / 4); i += 512) {
        const int c = (i % (FF / 4)) * 4, gs = 4 * pm + i / (FF / 4), s = gs & 1, grp = gs >> 1; const bool first = (grp & 31) == 0;
        const float* h0 = HU + (size_t)grp * 4 * FF2; const float* hp = HU + (size_t)(grp - 1) * 4 * FF2;
        const f32x4 z4 = (f32x4){0.f, 0.f, 0.f, 0.f};
        float zz[4];
#pragma unroll
        for (int half = 0; half < 2; ++half) {
            const int cc = half * FF + c;
            const f32x4 ut = *(const f32x4*)(h0 + (size_t)s * FF2 + cc);
            const f32x4 u1 = s ? *(const f32x4*)(h0 + cc) : (first ? z4 : *(const f32x4*)(hp + 3 * (size_t)FF2 + cc));
            const f32x4 u2 = s ? (first ? z4 : *(const f32x4*)(hp + 3 * (size_t)FF2 + cc)) : (first ? z4 : *(const f32x4*)(hp + 2 * (size_t)FF2 + cc));
            const f32x4 cv = *(const f32x4*)(cb + cc) + *(const f32x4*)(cw + cc) * u2 + *(const f32x4*)(cw + FF2 + cc) * u1 + *(const f32x4*)(cw + 2 * FF2 + cc) * ut;
#pragma unroll
            for (int j = 0; j < 4; ++j) zz[j] = half ? zz[j] * cv[j] : cv[j] * sigmoidf_(cv[j]);
        }
        u32x2 w; w.x = cvtpk(zz[0], zz[1]); w.y = cvtpk(zz[2], zz[3]);
        *(u32x2*)(Z + (size_t)(grp * 128 + s) * FF + c) = w;
    }
}

constexpr int NPH = 20;
constexpr int LDS_BYTES = 147456;
__global__ void __launch_bounds__(512, 2) mega(Params p) {
    extern __shared__ __attribute__((aligned(16))) unsigned char lds_raw[];
    LAS unsigned char* lds = (LAS unsigned char*)lds_raw;
    cg::grid_group grid = cg::this_grid();
    const int G = gridDim.x, bx = blockIdx.x;
    const int ngw = G * 8;
#define PH_BEGIN int tid = threadIdx.x; asm volatile("" : "+v"(tid)); const int lane = tid & 63, wave = __builtin_amdgcn_readfirstlane(tid >> 6), gw = bx * 8 + wave; (void)lane; (void)gw;
    unsigned char* ws = p.ws;
    unsigned* ctl = (unsigned*)(ws + WS_CTL);
    float* out = p.out;
    bf16_t* XN = (bf16_t*)(ws + WS_A); bf16_t* Y = (bf16_t*)(ws + WS_Y); bf16_t* P = (bf16_t*)(ws + WS_P); float* X2 = (float*)(ws + WS_X2);
    unsigned short* WL = (unsigned short*)(ws + WS_WL); bf16_t* AB = (bf16_t*)(ws + WS_KMOD); bf16_t* Gt = (bf16_t*)(ws + WS_G);
    bf16_t* KK = (bf16_t*)((unsigned char*)out + DO_KK); bf16_t* ACT = (bf16_t*)((unsigned char*)out + DO_ACT);
    float* ROPE = (float*)(ws + WS_ROPE); bf16_t* MEMN = (bf16_t*)(ws + WS_MEMN); bf16_t* MEMKV = (bf16_t*)(ws + WS_MEMKV); float* LSE = (float*)(ws + WS_LSE); float* SSQ = (float*)(ws + WS_SSQ); float* RS = (float*)(ws + WS_RS);
    bf16_t* XN1 = (bf16_t*)(ws + WS_XN1); bf16_t* Y1 = (bf16_t*)(ws + WS_Y1); bf16_t* OG = (bf16_t*)(ws + WS_OG);
#ifndef PHMASK
#define PHMASK 0xfffff
#endif
#define IN(k) ((((PHMASK) >> (k)) & 1) && p.ph_lo <= (k) && (k) < p.ph_hi)
#define SYNC(k) do { if (IN(k) && IN((k) + 1)) xcd_barrier(xbar); } while (0)
    if (p.ph_lo > 1000) grid.sync();
    { volatile LAS unsigned* st = (volatile LAS unsigned*)(lds + 140032); if (threadIdx.x == 0) { st[0] = 0u; st[1] = 0u; } __syncthreads(); }
    const XcdBarrier xbar = xcd_barrier_post(ctl + 4096, (volatile LAS unsigned*)(lds + 140032));

    if (IN(0)) { PH_BEGIN
        LAS float* scr = (LAS float*)(lds + wave * 16384);
        const float* an = p.in[I_ATTN_NORM]; const float* fn = p.in[I_FFN_NORM]; const float* mn = p.in[I_MEM_NORM];
        constexpr int C0 = 16 * 88, C1 = 16 * 32, C2 = 16 * 48, C3 = 16 * 32, C4 = 8 * 32, C5 = 16 * 16, C6 = 16 * 176, C7 = 44 * 32, C8 = 24, C9 = 48;
        constexpr int NITEMS = C0 + C1 + C2 + C3 + C4 + 2 * C5 + 2 * C6 + 2 * C7 + 2 * C8 + C9;
        for (int it = gw; it < NITEMS; it += ngw) {
            int r = it;
            if (r < C0) { const int nb = AIN / 32; tr_item(p.in[I_A_W_IN], AIN, an, (bf16_t*)(ws + WS_WAIN), D, 0, (r % nb) * 32, (r / nb) * 64, (r % nb) * 32, scr, lane); continue; } r -= C0;
            if (r < C1) { const int nb = 32; tr_item(p.in[I_A_W_OUT], D, nullptr, (bf16_t*)(ws + WS_WAOUT), D, 0, (r % nb) * 32, (r / nb) * 64, (r % nb) * 32, scr, lane); continue; } r -= C1;
            if (r < C2) { const int nb = 48; tr_item(p.in[I_KV_W], 1536, p.in[I_KV_NORM], (bf16_t*)(ws + WS_WIN1), D, 0, (r % nb) * 32, (r / nb) * 64, (r % nb) * 32, scr, lane); continue; } r -= C2;
            if (r < C3) { const int nb = 32; tr_item(p.in[I_B_W_IN], D, an + D, (bf16_t*)(ws + WS_WIN1), D, 0, 1536 + (r % nb) * 32, (r / nb) * 64, (r % nb) * 32, scr, lane); continue; } r -= C3;
            if (r < C4) { const int nb = 32; tr_item(p.in[I_B_W_OUT], D, nullptr, (bf16_t*)(ws + WS_WBOUT), 512, 0, (r % nb) * 32, (r / nb) * 64, (r % nb) * 32, scr, lane); continue; } r -= C4;
            if (r < 2 * C5) { const int l = r / C5; r -= l * C5; const int nb = 16; tr_item(p.in[I_MEM_W_KV] + (size_t)l * D * 512, 512, mn + l * D, (bf16_t*)(ws + WS_WMEM), D, 0, l * 512 + (r % nb) * 32, (r / nb) * 64, (r % nb) * 32, scr, lane); continue; } r -= 2 * C5;
            if (r < 2 * C6) { const int l = r / C6; r -= l * C6; const int nb = 176; const int n0 = (r % nb) * 32; const int drow = (n0 < FF) ? 256 * (n0 / 128) + (n0 % 128) : 256 * ((n0 - FF) / 128) + 128 + ((n0 - FF) % 128);
                tr_item(p.in[I_FFN_W_UP] + (size_t)l * D * FF2, FF2, fn + l * D, (bf16_t*)(ws + (l ? WS_WUP1 : WS_WUP0)), D, 0, drow, (r / nb) * 64, n0, scr, lane); continue; } r -= 2 * C6;
            if (r < 2 * C7) { const int l = r / C7; r -= l * C7; const int nb = 32; tr_item(p.in[I_FFN_W_DOWN] + (size_t)l * FF * D, D, nullptr, (bf16_t*)(ws + (l ? WS_WDN1 : WS_WDN0)), FF, 0, (r % nb) * 32, (r / nb) * 64, (r % nb) * 32, scr, lane); continue; } r -= 2 * C7;
            if (r < C8) { tr_item(p.in[I_A_W2], RW, nullptr, (bf16_t*)(ws + WS_WLORA), 256, 0, r * 32, 0, r * 32, scr, lane); continue; } r -= C8;
            if (r < C8) { tr_item(p.in[I_A_A2], RW, nullptr, (bf16_t*)(ws + WS_WLORA), 256, 64, 768 + r * 32, 0, r * 32, scr, lane); continue; } r -= C8;
            { const int nb = 24; tr_item(p.in[I_A_G2], RW, nullptr, (bf16_t*)(ws + WS_WLORA), 256, 128, 1536 + (r % nb) * 32, (r / nb) * 64, (r % nb) * 32, scr, lane); }
        }
        { bf16_t* WLr = (bf16_t*)(ws + WS_WLORA);
          for (int i = bx * 512 + tid; i < 2304 * 32; i += G * 512) { const int row = i >> 5, c8 = (i & 31) * 8; const int grp = row / 768;
              const bool nz = (grp == 0) ? (c8 < 64) : (grp == 1) ? (c8 >= 64 && c8 < 128) : (c8 >= 128);
              if (!nz) *(u32x4*)(WLr + (size_t)row * 256 + c8) = (u32x4){0u, 0u, 0u, 0u}; } }
        for (int i = bx * 512 + tid; i < T * 32; i += G * 512) { const int pos = i >> 5, f = i & 31; const float inv = powf(10000.0f, -(float)(2 * f) / 64.0f); const float ang = (float)pos * inv;
            ROPE[i] = cosf(ang); ROPE[T * 32 + i] = sinf(ang); }
        rms_pass(p.in[I_X], XN, M, gw, ngw, lane, RS);
        rms_pass(p.in[I_MEM], MEMN, NB * NMEM, gw, ngw, lane);
    }
    SYNC(0);
    if (IN(1)) {
        { pg8::Gemm g{XN, (const bf16_t*)(ws + WS_WAIN), M, AIN, D}; pg8::StaticOrder S; S.init(M, AIN, G, bx); EpiBf16 E{P, AIN, RS}; pg8::gemm_phase(lds, g, S, E); }
        { pg8::Gemm g{MEMN, (const bf16_t*)(ws + WS_WMEM), 2048, D, D}; pg8::StaticOrder S; S.init(2048, D, G, (bx + 128) % G); EpiBf16 E{MEMKV, D, nullptr}; pg8::gemm_phase(lds, g, S, E); }
    }
    SYNC(1);
    if (IN(2)) { PH_BEGIN
        const float* mu = p.in[I_A_MU];
        for (int i0 = bx * 512 + tid; i0 < M * 32; i0 += G * 512 * 4) {
            u32x4 wc_[4], wp_[4];
#pragma unroll
            for (int u = 0; u < 4; ++u) { const int i = i0 + u * G * 512; const int tok = i >> 5, lc = i & 31; const bool first = (tok & (T - 1)) == 0; const int col = 2304 + lc * 8;
                wc_[u] = *(const u32x4*)(P + (size_t)tok * AIN + col); wp_[u] = *(const u32x4*)(P + (size_t)(first ? tok : tok - 1) * AIN + col); }
#pragma unroll
            for (int u = 0; u < 4; ++u) { const int i = i0 + u * G * 512; const int tok = i >> 5, lc = i & 31; const bool first = (tok & (T - 1)) == 0; const int col = 2304 + lc * 8, q = lc >> 3;
                float pc[8], pp[8], xs[8];
                unpack8(wc_[u], pc); unpack8(wp_[u], pp);
                const f32x4 m0 = *(const f32x4*)(mu + col), m1 = *(const f32x4*)(mu + col + 4);
#pragma unroll
                for (int j = 0; j < 8; ++j) { const float pv = first ? 0.f : pp[j]; const float x = pc[j] + (pv - pc[j]) * (j < 4 ? m0[j] : m1[j - 4]); xs[j] = (q == 0) ? tanhf(x) : (q == 1) ? x : sigmoidf_(x); }
                *(u32x4*)(ACT + (size_t)tok * 256 + lc * 8) = pack8(xs); }
        }
    }
    SYNC(2);
    if (IN(3)) {
        pg8::Gemm g{ACT, (const bf16_t*)(ws + WS_WLORA), M, 2304, 256}; pg8::StaticOrder S; S.init(M, 2304, G, bx);
        EpiLora E{p.in[I_A_W0], p.in[I_A_A0], WL, AB, Gt};
        pg8::gemm_phase(lds, g, S, E);
    }
    SYNC(3);
    if (IN(4)) { PH_BEGIN
        unsigned char* CKB = (unsigned char*)out + 48 * MiB; float* SBUF = (float*)(ws + WS_SSQ);
        constexpr size_t CKWIN = (size_t)96 * WINCH * CK_BYTES;
        constexpr int NPT = 96 * (WINCH / 8);
#define PREP_TASK(pw_, u_) do { const int u__ = (u_); const int hh__ = u__ / (WINCH / 8), cw__ = (u__ % (WINCH / 8)) * 8 + wave; \
            rwkv_prep2(lds + wave * PREP_LDS, hh__, (pw_) * WINCH + cw__, CKB + (size_t)((pw_) & 1) * CKWIN + (size_t)(hh__ * WINCH + cw__) * CK_BYTES, P, WL, AB, p.in[I_A_K_K], p.in[I_A_MU], p.in[I_A_K_A], p.in[I_A_R_K], LSE, lane); } while (0)
#define XU(x_, t_) ((((x_) + 8 * ((t_) >> 2)) * 4) + ((t_) & 3))
#define TASK_OF(k_, pw_, u_, ok_) do { const int k__ = (k_); if (k__ < 2) { pw_ = 0; const int t__ = (bx >> 3) + 32 * k__; ok_ = t__ < 48; u_ = XU(bx & 7, ok_ ? t__ : 0); } \
            else { pw_ = 1 + ((k__ - 2) >> 1); u_ = XU(bx & 7, ((bx - 96) >> 3) * 2 + ((k__ - 2) & 1)); ok_ = pw_ < NWIN; } } while (0)
#define TASK_CHUNK(pw_, u_, hh_, cc_, rec_) do { hh_ = (u_) / (WINCH / 8); const int cw__ = ((u_) % (WINCH / 8)) * 8 + wave; cc_ = (pw_) * WINCH + cw__; rec_ = CKB + (size_t)((pw_) & 1) * CKWIN + (size_t)(hh_ * WINCH + cw__) * CK_BYTES; } while (0)
        if (bx >= 96) {
            int pw, u, hh, cc; bool ok; unsigned char* rec;
            for (int k = 0; k < 2 * NWIN; ++k) {
                TASK_OF(k, pw, u, ok); TASK_CHUNK(pw, u, hh, cc, rec);
                if (ok) rwkv_prep2(lds + wave * PREP_LDS, hh, cc, rec, P, WL, AB, p.in[I_A_K_K], p.in[I_A_MU], p.in[I_A_K_A], p.in[I_A_R_K], LSE, lane);
                if (k & 1) xcd_barrier(xbar);
            }
            xcd_barrier(xbar);
        } else {
            for (int t = (bx >> 3); t < 48; t += 32) PREP_TASK(0, XU(bx & 7, t));
            xcd_barrier(xbar);
            for (int win = 0; win < NWIN; ++win) {
                rwkv_seq_window(lds, bx, win, CKB + (size_t)(win & 1) * CKWIN, SBUF, Y, tid); asm volatile("s_waitcnt lgkmcnt(0)" ::: "memory"); __builtin_amdgcn_s_barrier(); asm volatile("" ::: "memory");
                if (win + 1 < NWIN && bx < 64) PREP_TASK(win + 1, XU(bx & 7, 40 + (bx >> 3)));
                xcd_barrier(xbar);
            }
        }
#undef TASK_OF
#undef XU
#undef TASK_CHUNK
#undef PREP_TASK
        {
#define MEM0_DESC(v_) AttnDesc{P + (size_t)((v_) >> 5) * T * AIN + SHIFTW + (((v_) >> 3) & 3) * 64, MEMKV + (size_t)((v_) >> 5) * NMEM * D + (((v_) >> 3) & 3) * 64, MEMKV + (size_t)((v_) >> 5) * NMEM * D + 256 + (((v_) >> 3) & 3) * 64, \
                Y + (size_t)((v_) >> 5) * T * D + RW + (((v_) >> 3) & 3) * 64, nullptr, p.in[I_MEM_Q_NORM], p.in[I_MEM_K_NORM], AIN, D, D, 0, 1, ((v_) & 7) * 4}
            AttnDesc cur = MEM0_DESC(bx); AttnRaw R; attn_issue<false>(cur, R, tid);
            for (int v = bx; v < 256; v += G) { const bool has = v + G < 256; const AttnDesc nd = MEM0_DESC(has ? v + G : v); attn_body<false>(lds, cur, R, nullptr, has, nd); cur = nd; }
#undef MEM0_DESC
        }
    }
    SYNC(4);
    if (IN(5)) { PH_BEGIN
        const float* mu = p.in[I_A_MU]; const float* lw = p.in[I_A_LNX_W]; const float* lb = p.in[I_A_LNX_B];
        for (int i0 = bx * 512 + tid; i0 < M * 96; i0 += G * 512 * 4) {
            u32x4 wy[4], wg[4], wc_[4], wp_[4]; float rk[4];
#pragma unroll
            for (int u = 0; u < 4; ++u) { const int i = i0 + u * G * 512; const int tok = i / 96, c8 = (i % 96) * 8; const bool first = (tok & (T - 1)) == 0;
                wy[u] = *(const u32x4*)(Y + (size_t)tok * D + c8); wg[u] = __builtin_nontemporal_load((const u32x4*)(Gt + (size_t)tok * RW + c8));
                wc_[u] = *(const u32x4*)(P + (size_t)tok * AIN + 1536 + c8); wp_[u] = *(const u32x4*)(P + (size_t)(first ? tok : tok - 1) * AIN + 1536 + c8);
                rk[u] = LSE[(size_t)tok * 12 + (c8 >> 6)]; }
#pragma unroll
            for (int u = 0; u < 4; ++u) { const int i = i0 + u * G * 512; const int tok = i / 96, c8 = (i % 96) * 8; const bool first = (tok & (T - 1)) == 0;
                float y[8], g[8], pc[8], pp[8];
                unpack8(wy[u], y); unpack8(wg[u], g); unpack8(wc_[u], pc); unpack8(wp_[u], pp);
                float s1 = 0.f;
#pragma unroll
                for (int j = 0; j < 8; ++j) s1 += y[j];
                const float mean = red8(s1) * (1.f / 64.f);
                float s2 = 0.f;
#pragma unroll
                for (int j = 0; j < 8; ++j) { y[j] -= mean; s2 += y[j] * y[j]; }
                const float rstd = rsqrtf(red8(s2) * (1.f / 64.f) + LNX_EPS);
                const f32x4 mA = *(const f32x4*)(mu + 1536 + c8), mB = *(const f32x4*)(mu + 1536 + c8 + 4), lwA = *(const f32x4*)(lw + c8), lwB = *(const f32x4*)(lw + c8 + 4), lbA = *(const f32x4*)(lb + c8), lbB = *(const f32x4*)(lb + c8 + 4);
                float o[8];
#pragma unroll
                for (int j = 0; j < 8; ++j) { const float pv = first ? 0.f : pp[j]; const float vv = pc[j] + (pv - pc[j]) * (j < 4 ? mA[j] : mB[j - 4]);
                    o[j] = (y[j] * rstd * (j < 4 ? lwA[j] : lwB[j - 4]) + (j < 4 ? lbA[j] : lbB[j - 4]) + rk[u] * vv) * g[j]; }
                *(u32x4*)(Y + (size_t)tok * D + c8) = pack8(o); }
        }
    }
    SYNC(5);
    if (IN(6)) { pg8::Gemm g{Y, (const bf16_t*)(ws + WS_WAOUT), M, D, D}; pg8::StaticOrder S; S.init(M, D, G, bx); EpiResid E{nullptr, XN, nullptr, XN, SSQ}; pg8::gemm_phase(lds, g, S, E); }
    SYNC(6);
#define FOR_PANELS(Nv_, BODY_) do { pg8::StaticOrder S_; S_.init(M, (Nv_), G, bx); pg8::Unit u_; int last_ = -1; for (int i_ = 0; S_.next(i_, u_); ++i_) if (u_.pm != last_) { last_ = u_.pm; const int pm_ = u_.pm; BODY_ } } while (0)
#define RS_PANEL() { if (tid < 256) { const int r_ = pm_ * 256 + tid; const f32x4* q_ = (const f32x4*)(SSQ + (size_t)r_ * 16); const f32x4 a_ = (q_[0] + q_[1]) + (q_[2] + q_[3]); \
        RS[r_] = rsqrtf(((a_[0] + a_[1]) + (a_[2] + a_[3])) * (1.f / D) + RMS_EPS); } }
    if (IN(8)) { { PH_BEGIN FOR_PANELS(FF2, RS_PANEL()); __syncthreads(); }
        pg8::Gemm g{XN, (const bf16_t*)(ws + WS_WUP0), M, FF2, D}; pg8::StaticOrder S; S.init(M, FF2, G, bx); EpiFFN E{p.in[I_FFN_CONV_W], p.in[I_FFN_CONV_B], P, (float*)(ws + WS_HU0), RS}; pg8::gemm_phase(lds, g, S, E); }
    SYNC(8);
    if (IN(10)) { { PH_BEGIN FOR_PANELS(D, { fixup_panel(tid, pm_, p.in[I_FFN_CONV_W], p.in[I_FFN_CONV_B], (const float*)(ws + WS_HU0), P); }); __syncthreads(); }
        pg8::Gemm g{P, (const bf16_t*)(ws + WS_WDN0), M, D, FF}; pg8::StaticOrder S; S.init(M, D, G, bx); EpiResid E{nullptr, XN, nullptr, XN1, SSQ}; pg8::gemm_phase(lds, g, S, E); }
    SYNC(10);
    if (IN(12)) { { PH_BEGIN FOR_PANELS(IN1, RS_PANEL()); __syncthreads(); }
        pg8::Gemm g{XN1, (const bf16_t*)(ws + WS_WIN1), M, IN1, D}; pg8::StaticOrder S; S.init(M, IN1, G, bx); EpiBf16 E{P, IN1, RS}; pg8::gemm_phase(lds, g, S, E); }
    SYNC(12);
    if (IN(13)) { PH_BEGIN
        {
#define DIL_DESC(u_, dsc) do { const int gi = (u_) >> 10, r = (u_) & 1023, b = r >> 7, hs = (r >> 5) & 3, rn = r & 31; \
                const int d = (gi == 0) ? 1 : (gi == 1) ? 4 : 16, nb = 32 / d, head = gi * 4 + hs; const bf16_t* Pb = P + (size_t)b * T * IN1; \
                dsc = AttnDesc{Pb + 1536 + head * 64, Pb + head * 64, Pb + RW + head * 64, OG + ((size_t)gi * M + (size_t)b * T) * 256 + hs * 64, LSE + ((size_t)gi * M + (size_t)b * T) * 4 + hs, \
                               p.in[I_B_Q_NORM], p.in[I_KV_K_NORM], IN1, IN1, 256, rn / nb, d, rn % nb}; } while (0)
            AttnDesc cur, nd; AttnRaw R; DIL_DESC(bx, cur); attn_issue<true>(cur, R, tid);
            for (int u = bx; u < 3072; u += G) { const bool has = u + G < 3072; DIL_DESC(has ? u + G : u, nd); attn_body<true>(lds, cur, R, ROPE, has, nd); cur = nd; }
#undef DIL_DESC
        }
        {
#define MEM1_DESC(v_) AttnDesc{P + (size_t)((v_) >> 5) * T * IN1 + 2304 + (((v_) >> 3) & 3) * 64, MEMKV + (size_t)((v_) >> 5) * NMEM * D + 512 + (((v_) >> 3) & 3) * 64, MEMKV + (size_t)((v_) >> 5) * NMEM * D + 768 + (((v_) >> 3) & 3) * 64, \
                Y1 + (size_t)((v_) >> 5) * T * 512 + 256 + (((v_) >> 3) & 3) * 64, nullptr, p.in[I_MEM_Q_NORM] + 64, p.in[I_MEM_K_NORM] + 64, IN1, D, 512, 0, 1, ((v_) & 7) * 4}
            AttnDesc cur = MEM1_DESC(bx); AttnRaw R; attn_issue<false>(cur, R, tid);
            for (int v = bx; v < 256; v += G) { const bool has = v + G < 256; const AttnDesc nd = MEM1_DESC(has ? v + G : v); attn_body<false>(lds, cur, R, nullptr, has, nd); cur = nd; }
#undef MEM1_DESC
        }
    }
    SYNC(13);
    if (IN(14)) { PH_BEGIN
        for (int i0 = bx * 512 + tid; i0 < M * 32; i0 += G * 512 * 4) {
            u32x4 wa[4], wb[4], wc_[4]; float l0[4], l1[4], l2[4];
#pragma unroll
            for (int u = 0; u < 4; ++u) { const int i = i0 + u * G * 512; const int tok = i >> 5, c8 = (i & 31) * 8, slot = c8 >> 6;
                l0[u] = LSE[((size_t)0 * M + tok) * 4 + slot]; l1[u] = LSE[((size_t)1 * M + tok) * 4 + slot]; l2[u] = LSE[((size_t)2 * M + tok) * 4 + slot];
                wa[u] = __builtin_nontemporal_load((const u32x4*)(OG + ((size_t)0 * M + tok) * 256 + c8)); wb[u] = __builtin_nontemporal_load((const u32x4*)(OG + ((size_t)1 * M + tok) * 256 + c8)); wc_[u] = __builtin_nontemporal_load((const u32x4*)(OG + ((size_t)2 * M + tok) * 256 + c8)); }
#pragma unroll
            for (int u = 0; u < 4; ++u) { const int i = i0 + u * G * 512; const int tok = i >> 5, c8 = (i & 31) * 8;
                const float mxl = fmaxf(l0[u], fmaxf(l1[u], l2[u])); const float e0 = __expf(l0[u] - mxl), e1 = __expf(l1[u] - mxl), e2 = __expf(l2[u] - mxl); const float inv = 1.f / (e0 + e1 + e2);
                float a[8], b[8], c[8], o[8];
                unpack8(wa[u], a); unpack8(wb[u], b); unpack8(wc_[u], c);
#pragma unroll
                for (int j = 0; j < 8; ++j) o[j] = (e0 * a[j] + e1 * b[j] + e2 * c[j]) * inv;
                *(u32x4*)(Y1 + (size_t)tok * 512 + c8) = pack8(o); }
        }
    }
    SYNC(14);
    if (IN(15)) { pg8::Gemm g{Y1, (const bf16_t*)(ws + WS_WBOUT), M, D, 512}; pg8::StaticOrder S; S.init(M, D, G, bx); EpiResid E{nullptr, XN1, nullptr, XN1, SSQ}; pg8::gemm_phase(lds, g, S, E); }
    SYNC(15);
    if (IN(17)) { { PH_BEGIN FOR_PANELS(FF2, RS_PANEL()); __syncthreads(); }
        pg8::Gemm g{XN1, (const bf16_t*)(ws + WS_WUP1), M, FF2, D}; pg8::StaticOrder S; S.init(M, FF2, G, bx); EpiFFN E{p.in[I_FFN_CONV_W] + 3 * FF2, p.in[I_FFN_CONV_B] + FF2, P, (float*)(ws + WS_HU1), RS}; pg8::gemm_phase(lds, g, S, E); }
    SYNC(17);
    if (IN(19)) { { PH_BEGIN FOR_PANELS(D, { fixup_panel(tid, pm_, p.in[I_FFN_CONV_W] + 3 * FF2, p.in[I_FFN_CONV_B] + FF2, (const float*)(ws + WS_HU1), P); }); __syncthreads(); }
        pg8::Gemm g{P, (const bf16_t*)(ws + WS_WDN1), M, D, FF}; pg8::StaticOrder S; S.init(M, D, G, bx); EpiResid E{nullptr, XN1, out, nullptr, nullptr}; pg8::gemm_phase(lds, g, S, E); }
#undef IN
#undef SYNC
}

extern "C" void kernel_launch(void* const* d_in, const int* in_sizes, int n_in, void* d_out, int out_size, void* d_ws, size_t ws_size, hipStream_t stream) {
    static int grid = 0;
    if (grid == 0) {
        if (n_in != 31 || ws_size < WS_END) { fprintf(stderr, "kernel_launch: unexpected n_in %d / ws %zu\n", n_in, ws_size); grid = -1; return; }
        int dev = 0, cus = 0, per_cu = 0;
        hipGetDevice(&dev); hipDeviceGetAttribute(&cus, hipDeviceAttributeMultiprocessorCount, dev);
        if (hipFuncSetAttribute((const void*)mega, hipFuncAttributeMaxDynamicSharedMemorySize, LDS_BYTES) != hipSuccess) { fprintf(stderr, "kernel_launch: hipFuncSetAttribute failed\n"); grid = -1; return; }
        if (hipOccupancyMaxActiveBlocksPerMultiprocessor(&per_cu, (const void*)mega, 512, LDS_BYTES) != hipSuccess || per_cu < 1) { fprintf(stderr, "kernel_launch: occupancy query says %d\n", per_cu); per_cu = 1; }
        (void)hipGetLastError();
        grid = cus * 1;
        if (grid > 256) grid = 256;
    }
    if (grid < 0) return;
    (void)hipMemsetAsync((char*)d_ws + WS_CTL, 0, 65536, stream);
    Params p{};
    for (int i = 0; i < 31; ++i) p.in[i] = (const float*)d_in[i];
    p.out = (float*)d_out; p.ws = (unsigned char*)d_ws; p.ph_lo = 0; p.ph_hi = NPH;
    void* args[] = {&p};
    hipError_t e = hipLaunchCooperativeKernel((const void*)mega, dim3(grid), dim3(512), args, LDS_BYTES, stream);
    if (e != hipSuccess) fprintf(stderr, "cooperative launch failed: %s (grid %d)\n", hipGetErrorString(e), grid);
}
```

```cpp
#include <hip/hip_runtime.h>
#include <hip/hip_cooperative_groups.h>
#include <cstdio>
#include <cstdint>
namespace cg = cooperative_groups;

#define LAS __attribute__((address_space(3)))
typedef unsigned short bf16_t;
typedef short bf16x8 __attribute__((ext_vector_type(8)));
typedef short s16x4 __attribute__((ext_vector_type(4)));
typedef float f32x4 __attribute__((ext_vector_type(4)));
typedef float f32x2 __attribute__((ext_vector_type(2)));
typedef unsigned u32x4 __attribute__((ext_vector_type(4)));
typedef unsigned u32x2 __attribute__((ext_vector_type(2)));
typedef __bf16 bf16x2_t __attribute__((ext_vector_type(2)));

constexpr int NB = 8, T = 4096, D = 1024, M = NB * T;
constexpr int AIN = 2816, SHIFTW = 2560, RW = 768, FF = 2816, FF2 = 5632, IN1 = 2560, NMEM = 256;
constexpr float RMS_EPS = 1e-6f, LNX_EPS = 64e-5f;

constexpr size_t MiB = 1u << 20;
constexpr size_t WS_CTL = 0;
constexpr size_t WS_WAIN = 1 * MiB;
constexpr size_t WS_WAOUT = WS_WAIN + (size_t)AIN * D * 2;
constexpr size_t WS_WIN1 = WS_WAOUT + (size_t)D * D * 2;
constexpr size_t WS_WBOUT = WS_WIN1 + (size_t)IN1 * D * 2;
constexpr size_t WS_WMEM = WS_WBOUT + (size_t)D * 512 * 2;
constexpr size_t WS_WUP0 = WS_WMEM + (size_t)D * D * 2;
constexpr size_t WS_WUP1 = WS_WUP0 + (size_t)FF2 * D * 2;
constexpr size_t WS_WDN0 = WS_WUP1 + (size_t)FF2 * D * 2;
constexpr size_t WS_WDN1 = WS_WDN0 + (size_t)D * FF * 2;
constexpr size_t WS_WLORA = WS_WDN1 + (size_t)D * FF * 2;
constexpr size_t WS_ROPE = WS_WLORA + (size_t)2304 * 256 * 2;
constexpr size_t WS_MEMN = WS_ROPE + (size_t)T * 32 * 4 * 2;
constexpr size_t WS_MEMKV = WS_MEMN + (size_t)2048 * D * 2;
constexpr size_t WS_LSE = WS_MEMKV + (size_t)2048 * D * 2;
constexpr size_t WS_SSQ = WS_LSE + (size_t)3 * M * 4 * 4;
constexpr size_t WS_RS = WS_SSQ + (size_t)M * 16 * 4;
constexpr size_t WS_WEND = WS_RS + (size_t)M * 4;
static_assert(WS_WEND <= 64 * MiB, "weight region");
constexpr size_t WS_A = 64 * MiB;
constexpr size_t WS_Y = 128 * MiB;
constexpr size_t WS_X2 = 64 * MiB;
constexpr size_t WS_P = 192 * MiB;
constexpr size_t WS_S = 368 * MiB;
constexpr size_t WS_WL = WS_S, WS_KMOD = WS_S + 48 * MiB, WS_G = WS_S + 96 * MiB;
constexpr size_t WS_HU0 = WS_S;
constexpr size_t WS_XN1 = WS_S, WS_Y1 = WS_S + 64 * MiB, WS_OG = WS_S + 96 * MiB, WS_HU1 = WS_S + 64 * MiB;
constexpr size_t WS_END = 512 * MiB;
constexpr size_t DO_KK = 0, DO_KKA = 48 * MiB, DO_ACT = 96 * MiB;

__device__ __forceinline__ unsigned cvtpk(float lo, float hi) { f32x2 v = {lo, hi}; bf16x2_t b = __builtin_convertvector(v, bf16x2_t); return __builtin_bit_cast(unsigned, b); }
__device__ __forceinline__ float bflo(unsigned w) { return __uint_as_float(w << 16); }
__device__ __forceinline__ float bfhi(unsigned w) { return __uint_as_float(w & 0xffff0000u); }
__device__ __forceinline__ float bf2f(bf16_t b) { return __uint_as_float(((unsigned)b) << 16); }
__device__ __forceinline__ bf16_t f2bf(float f) { return (bf16_t)(cvtpk(f, 0.f) & 0xffffu); }
__device__ __forceinline__ void unpack8(u32x4 w, float* o) { o[0] = bflo(w.x); o[1] = bfhi(w.x); o[2] = bflo(w.y); o[3] = bfhi(w.y); o[4] = bflo(w.z); o[5] = bfhi(w.z); o[6] = bflo(w.w); o[7] = bfhi(w.w); }
__device__ __forceinline__ u32x4 pack8(const float* v) { u32x4 w; w.x = cvtpk(v[0], v[1]); w.y = cvtpk(v[2], v[3]); w.z = cvtpk(v[4], v[5]); w.w = cvtpk(v[6], v[7]); return w; }
__device__ __forceinline__ float wave_sum(float v) {
#pragma unroll
    for (int o = 1; o < 64; o <<= 1) v += __shfl_xor(v, o);
    return v;
}
template <int CTRL> __device__ __forceinline__ float dpp_f(float x) { return __int_as_float(__builtin_amdgcn_update_dpp(0, __float_as_int(x), CTRL, 0xf, 0xf, true)); }
__device__ __forceinline__ float red8(float x) { x += dpp_f<0xB1>(x); x += dpp_f<0x4E>(x); x += dpp_f<0x141>(x); return x; }
__device__ __forceinline__ float sigmoidf_(float z) { return __builtin_amdgcn_rcpf(1.0f + __expf(-z)); }

namespace pg8 {
constexpr int BM = 256, BK = 64, HALF = 128, HTB = HALF * BK * 2, STAGE_BYTES = 8 * HTB, NXCD = 8, WGM = 8;
__host__ __device__ __forceinline__ int lds_byte(int r, int c) { const int st = (r >> 4) * 2 + (c >> 5), rr = r & 15, cc = c & 31, ob = rr * 64 + cc * 2; return st * 1024 + (ob ^ (((ob >> 9) & 1) << 5)); }
__host__ __device__ __forceinline__ void stage_rc(int b, int& R, int& C) { const int st = b / 1024, sb = b % 1024, swz = sb ^ (((sb >> 9) & 1) << 5); R = (st >> 1) * 16 + swz / 64; C = (st & 1) * 32 + (swz % 64) / 2; }
__host__ __device__ __forceinline__ int perm32(int rho) { const int n = rho >> 4, i = rho & 15; return 8 * (i >> 2) + 4 * n + (i & 3); }
struct Unit { int pm, pn; };
struct Gemm { const bf16_t* A; const bf16_t* Bt; int M, N, K; };
struct StaticOrder {
    int nM, nN, nwg, G, c;
    __device__ __forceinline__ void init(int M_, int N_, int G_, int c_) { nM = M_ / BM; nN = N_ / BM; nwg = nM * nN; G = G_; c = c_; }
    __device__ __forceinline__ bool next(int i, Unit& u) const {
        const long L = (long)i * G + c; if (L >= nwg) return false;
        int wgid = (int)L; { const int q = nwg / NXCD, r = nwg % NXCD, xcd = wgid % NXCD, off = wgid / NXCD; wgid = (xcd < r ? xcd * (q + 1) : r * (q + 1) + (xcd - r) * q) + off; }
        const int nig = WGM * nN, gid = wgid / nig, fm = gid * WGM, gsz = (nM - fm) < WGM ? (nM - fm) : WGM;
        u.pm = fm + ((wgid % nig) % gsz); u.pn = (wgid % nig) / gsz; return true;
    }
};
template <class Epi>
__device__ __forceinline__ void gemm_phase(LAS unsigned char* lds, const Gemm g, const StaticOrder& S, const Epi& E) {
    int tid = threadIdx.x; asm volatile("" : "+v"(tid));
    const int wid = __builtin_amdgcn_readfirstlane(tid >> 6), lane = tid & 63, wr = wid >> 2, wc = wid & 3, fr = lane & 15, fq = lane >> 4;
    int K_ = g.K; asm volatile("" : "+s"(K_));
    const int K = K_, nt = K / BK;
    unsigned voffA[2], voffB[2];
#pragma unroll
    for (int i = 0; i < 2; ++i) { int R, C; stage_rc(tid * 16 + i * 8192, R, C); const int Rb = Epi::PERM ? ((R & ~31) + perm32(R & 31)) : R;
        const int Ra = Epi::APERM ? (8 * (16 * (R >> 6) + (R & 15)) + ((R >> 4) & 3)) : R;
        voffA[i] = (unsigned)(Ra * K + C) * 2u; voffB[i] = (unsigned)(Rb * K + C) * 2u; }
    const size_t kstep = (size_t)(BK * 2);
    const size_t hstep = (size_t)HALF * K * 2;
    const size_t hstepA = Epi::APERM ? (size_t)4 * K * 2 : hstep;
    const size_t tstep = 2 * hstep;
    const unsigned ldsw = (unsigned)wid * 1024u;
    const int aoff = lds_byte(wr * 64 + fr, fq * 8), boff = lds_byte(wc * 32 + fr, fq * 8);
#define PG8_SA(b, h) (((b) * 2 + (h)) * HTB)
#define PG8_SB(b, h) ((4 + (b) * 2 + (h)) * HTB)
#define PG8_STAGE(bufoff, gbase, voff) do { _Pragma("unroll") for (int _i = 0; _i < 2; ++_i) \
        __builtin_amdgcn_global_load_lds((const unsigned*)((const char*)(gbase) + (voff)[_i]), (LAS unsigned*)(lds + (bufoff) + ldsw + _i * 8192), 16, 0, 0); } while (0)
#define PG8_LDA(dst, b, h) do { _Pragma("unroll") for (int m = 0; m < 4; ++m) _Pragma("unroll") for (int k = 0; k < 2; ++k) dst[m][k] = *(const LAS bf16x8*)(lds + PG8_SA(b, h) + aoff + m * 2048 + k * 1024); } while (0)
#define PG8_LDB(dst, b, h) do { _Pragma("unroll") for (int n = 0; n < 2; ++n) _Pragma("unroll") for (int k = 0; k < 2; ++k) dst[n][k] = *(const LAS bf16x8*)(lds + PG8_SB(b, h) + boff + n * 2048 + k * 1024); } while (0)
#define PG8_MMA(ai, bj, At, Bt) do { __builtin_amdgcn_s_setprio(1); _Pragma("unroll") for (int m = 0; m < 4; ++m) _Pragma("unroll") for (int n = 0; n < 2; ++n) _Pragma("unroll") for (int k = 0; k < 2; ++k) \
        acc[ai][bj][m][n] = __builtin_amdgcn_mfma_f32_16x16x32_bf16(Bt[n][k], At[m][k], acc[ai][bj][m][n], 0, 0, 0); __builtin_amdgcn_s_setprio(0); } while (0)
#define PG8_WAIT_V(n) asm volatile("s_waitcnt vmcnt(" #n ")" ::: "memory")
#define PG8_WAIT_L(n) asm volatile("s_waitcnt lgkmcnt(" #n ")" ::: "memory")
#define PG8_BAR __builtin_amdgcn_s_barrier()
#define PG8_SCHED __builtin_amdgcn_sched_barrier(0)
    Unit cur, nxt; int ui = 0;
    if (!S.next(0, cur)) return;
    f32x4 acc[2][2][4][2];
#pragma unroll
    for (int a = 0; a < 2; ++a)
#pragma unroll
        for (int b = 0; b < 2; ++b)
#pragma unroll
            for (int m = 0; m < 4; ++m)
#pragma unroll
                for (int n = 0; n < 2; ++n) acc[a][b][m][n] = (f32x4){0.f, 0.f, 0.f, 0.f};
    bf16x8 At[4][2], B0[2][2], B1[2][2];
    const char* cA = (const char*)g.A + (size_t)cur.pm * tstep; const char* cB = (const char*)g.Bt + (size_t)cur.pn * tstep;
    PG8_STAGE(PG8_SB(0, 0), cB, voffB); PG8_STAGE(PG8_SB(0, 1), cB + hstep, voffB); PG8_STAGE(PG8_SA(0, 0), cA, voffA); PG8_STAGE(PG8_SA(0, 1), cA + hstepA, voffA);
    if (wr == 1) PG8_BAR;
    PG8_WAIT_V(2); PG8_BAR;
    PG8_STAGE(PG8_SB(1, 0), cB + kstep, voffB); PG8_STAGE(PG8_SA(1, 0), cA + kstep, voffA); PG8_STAGE(PG8_SB(1, 1), cB + hstep + kstep, voffB);
    PG8_WAIT_V(6); PG8_BAR;
    for (;;) {
        const bool has_next = S.next(ui + 1, nxt);
        const char* nA = has_next ? (const char*)g.A + (size_t)nxt.pm * tstep : cA; const char* nB = has_next ? (const char*)g.Bt + (size_t)nxt.pn * tstep : cB;
        for (int t = 0; t < nt; t += 2) {
            const bool last = (t == nt - 2);
            const char* a1 = cA + (size_t)(t + 1) * kstep;
            const char* a2 = last ? nA : cA + (size_t)(t + 2) * kstep; const char* b2 = last ? nB : cB + (size_t)(t + 2) * kstep;
            const char* a3 = a2 + kstep; const char* b3 = b2 + kstep;
            PG8_LDB(B0, 0, 0); PG8_LDB(B1, 0, 1); PG8_SCHED; PG8_LDA(At, 0, 0); PG8_STAGE(PG8_SA(1, 1), a1 + hstepA, voffA);
            PG8_WAIT_V(8); PG8_WAIT_L(0); PG8_BAR; PG8_MMA(0, 0, At, B0); PG8_MMA(0, 1, At, B1); PG8_BAR; PG8_SCHED;
            PG8_LDA(At, 0, 1); PG8_STAGE(PG8_SB(0, 0), b2, voffB); PG8_STAGE(PG8_SB(0, 1), b2 + hstep, voffB); PG8_STAGE(PG8_SA(0, 0), a2, voffA);
            PG8_WAIT_V(8); PG8_WAIT_L(0); PG8_BAR; PG8_MMA(1, 0, At, B0); PG8_MMA(1, 1, At, B1); PG8_BAR; PG8_SCHED;
            PG8_LDB(B0, 1, 0); PG8_LDB(B1, 1, 1); PG8_SCHED; PG8_LDA(At, 1, 0); PG8_STAGE(PG8_SA(0, 1), a2 + hstepA, voffA);
            PG8_WAIT_V(8); PG8_WAIT_L(0); PG8_BAR; PG8_MMA(0, 0, At, B0); PG8_MMA(0, 1, At, B1); PG8_BAR; PG8_SCHED;
            PG8_LDA(At, 1, 1); PG8_STAGE(PG8_SB(1, 0), b3, voffB); PG8_STAGE(PG8_SB(1, 1), b3 + hstep, voffB); PG8_STAGE(PG8_SA(1, 0), a3, voffA);
            PG8_WAIT_V(8); PG8_WAIT_L(0); PG8_BAR; PG8_MMA(1, 0, At, B0); PG8_MMA(1, 1, At, B1); PG8_BAR; PG8_SCHED;
        }
        if (wr == 0) PG8_BAR;
        E(acc, cur, wr, wc, fr, fq);
        if (!has_next) break;
#pragma unroll
        for (int a = 0; a < 2; ++a)
#pragma unroll
            for (int b = 0; b < 2; ++b)
#pragma unroll
                for (int m = 0; m < 4; ++m)
#pragma unroll
                    for (int n = 0; n < 2; ++n) acc[a][b][m][n] = (f32x4){0.f, 0.f, 0.f, 0.f};
        cur = nxt; cA = nA; cB = nB; ++ui;
        if (wr == 1) PG8_BAR;
    }
    PG8_WAIT_V(0);
    PG8_BAR;
#undef PG8_SA
#undef PG8_SB
#undef PG8_STAGE
#undef PG8_LDA
#undef PG8_LDB
#undef PG8_MMA
#undef PG8_WAIT_V
#undef PG8_WAIT_L
#undef PG8_BAR
#undef PG8_SCHED
}
}
using pg8::Unit;

__device__ __forceinline__ float row_rs(const float* ssq, int row) {
    const f32x4* q = (const f32x4*)(ssq + (size_t)row * 16); const f32x4 a = q[0] + q[1] + q[2] + q[3];
    return rsqrtf(((a[0] + a[1]) + (a[2] + a[3])) * (1.f / D) + RMS_EPS);
}
#define ROW_SCALES8(sc, ssq_, ROWEXPR) do { f32x4 q_[8]; \
        _Pragma("unroll") for (int i_ = 0; i_ < 8; ++i_) q_[i_] = *(const f32x4*)((ssq_) + (size_t)(ROWEXPR) * 16 + 4 * fq); \
        _Pragma("unroll") for (int i_ = 0; i_ < 8; ++i_) { float s_ = (q_[i_][0] + q_[i_][1]) + (q_[i_][2] + q_[i_][3]); s_ += __shfl_xor(s_, 16); s_ += __shfl_xor(s_, 32); sc[i_] = rsqrtf(s_ * (1.f / D) + RMS_EPS); } } while (0)
struct EpiBf16 {
    static constexpr bool PERM = true, APERM = false;
    bf16_t* O; int ldc; const float* ssq;
    __device__ __forceinline__ void operator()(f32x4 (&acc)[2][2][4][2], const Unit& u, int wr, int wc, int fr, int fq) const {
        const int row0 = u.pm * 256 + wr * 64 + fr, col0 = u.pn * 256 + wc * 32 + 8 * fq;
        float scs[8];
#pragma unroll
        for (int i = 0; i < 8; ++i) scs[i] = ssq ? ssq[row0 + (i >> 2) * 128 + (i & 3) * 16] : 1.0f;
#pragma unroll
        for (int ai = 0; ai < 2; ++ai)
#pragma unroll
            for (int m = 0; m < 4; ++m) { const int row = row0 + ai * 128 + m * 16; bf16_t* rowp = O + (size_t)row * ldc + col0;
                const float sc = scs[ai * 4 + m];
#pragma unroll
                for (int bj = 0; bj < 2; ++bj) { const f32x4 v0 = acc[ai][bj][m][0] * sc, v1 = acc[ai][bj][m][1] * sc;
                    u32x4 w; w.x = cvtpk(v0[0], v0[1]); w.y = cvtpk(v0[2], v0[3]); w.z = cvtpk(v1[0], v1[1]); w.w = cvtpk(v1[2], v1[3]);
                    *(u32x4*)(rowp + bj * 128) = w; } }
    }
};
struct EpiResid {
    static constexpr bool PERM = true, APERM = false;
    const float* base; const bf16_t* baseb; float* out; bf16_t* XB; float* SSQ;
    __device__ __forceinline__ void operator()(f32x4 (&acc)[2][2][4][2], const Unit& u, int wr, int wc, int fr, int fq) const {
        const int row0 = u.pm * 256 + wr * 64 + fr, col0 = u.pn * 256 + wc * 32 + 8 * fq;
#pragma unroll
        for (int ai = 0; ai < 2; ++ai) {
            f32x4 bv[4][2][2];
#pragma unroll
            for (int m = 0; m < 4; ++m) { const size_t off = (size_t)(row0 + ai * 128 + m * 16) * D + col0;
#pragma unroll
                for (int bj = 0; bj < 2; ++bj) {
                    if (baseb) { const u32x4 w = *(const u32x4*)(baseb + off + bj * 128); bv[m][bj][0] = (f32x4){bflo(w.x), bfhi(w.x), bflo(w.y), bfhi(w.y)}; bv[m][bj][1] = (f32x4){bflo(w.z), bfhi(w.z), bflo(w.w), bfhi(w.w)}; }
                    else { bv[m][bj][0] = *(const f32x4*)(base + off + bj * 128); bv[m][bj][1] = *(const f32x4*)(base + off + bj * 128 + 4); } } }
            asm volatile("" ::: "memory");
#pragma unroll
            for (int m = 0; m < 4; ++m) { const int row = row0 + ai * 128 + m * 16; const size_t off = (size_t)row * D + col0; float ss = 0.f;
#pragma unroll
                for (int bj = 0; bj < 2; ++bj) {
                    const f32x4 o0 = bv[m][bj][0] + acc[ai][bj][m][0], o1 = bv[m][bj][1] + acc[ai][bj][m][1];
                    if (out) { __builtin_nontemporal_store(o0, (f32x4*)(out + off + bj * 128)); __builtin_nontemporal_store(o1, (f32x4*)(out + off + bj * 128 + 4)); }
                    if (XB) { u32x4 w; w.x = cvtpk(o0[0], o0[1]); w.y = cvtpk(o0[2], o0[3]); w.z = cvtpk(o1[0], o1[1]); w.w = cvtpk(o1[2], o1[3]); *(u32x4*)(XB + off + bj * 128) = w;
                        ss += (o0[0] * o0[0] + o0[1] * o0[1]) + (o0[2] * o0[2] + o0[3] * o0[3]) + (o1[0] * o1[0] + o1[1] * o1[1]) + (o1[2] * o1[2] + o1[3] * o1[3]); } }
                if (XB) { ss += __shfl_xor(ss, 16); ss += __shfl_xor(ss, 32); if (fq == 0) SSQ[(size_t)row * 16 + u.pn * 4 + wc] = ss; } }
            asm volatile("" ::: "memory");
        }
    }
};
struct EpiLora {
    static constexpr bool PERM = true, APERM = false;
    const float *w0, *a0; unsigned short* WL; bf16_t* AB; bf16_t* G;
    __device__ __forceinline__ void operator()(f32x4 (&acc)[2][2][4][2], const Unit& u, int wr, int wc, int fr, int fq) const {
        const int kind = u.pn / 3, row0 = u.pm * 256 + wr * 64 + fr;
#pragma unroll
        for (int bj = 0; bj < 2; ++bj) {
            const int c = (u.pn % 3) * 256 + bj * 128 + wc * 32 + 8 * fq;
            if (kind == 2) {
#pragma unroll
                for (int ai = 0; ai < 2; ++ai)
#pragma unroll
                    for (int m = 0; m < 4; ++m) { const int row = row0 + ai * 128 + m * 16; const f32x4 v0 = acc[ai][bj][m][0], v1 = acc[ai][bj][m][1];
                        u32x4 w; w.x = cvtpk(v0[0], v0[1]); w.y = cvtpk(v0[2], v0[3]); w.z = cvtpk(v1[0], v1[1]); w.w = cvtpk(v1[2], v1[3]);
                        *(u32x4*)(G + (size_t)row * RW + c) = w; }
            } else {
                const float* bp = (kind == 0 ? w0 : a0) + c;
                const f32x4 b0 = *(const f32x4*)bp, b1 = *(const f32x4*)(bp + 4);
#pragma unroll
                for (int ai = 0; ai < 2; ++ai)
#pragma unroll
                    for (int m = 0; m < 4; ++m) { const int row = row0 + ai * 128 + m * 16; float sg[8];
#pragma unroll
                        for (int j = 0; j < 4; ++j) { sg[j] = sigmoidf_(b0[j] + acc[ai][bj][m][0][j]); sg[4 + j] = sigmoidf_(b1[j] + acc[ai][bj][m][1][j]); }
                        if (kind == 0) { unsigned short h[8];
#pragma unroll
                            for (int j = 0; j < 8; ++j) h[j] = __builtin_bit_cast(unsigned short, (_Float16)(-0.60653066f * sg[j]));
                            u32x4 w; w.x = h[0] | ((unsigned)h[1] << 16); w.y = h[2] | ((unsigned)h[3] << 16); w.z = h[4] | ((unsigned)h[5] << 16); w.w = h[6] | ((unsigned)h[7] << 16);
                            *(u32x4*)(WL + (size_t)row * RW + c) = w; }
                        else *(u32x4*)(AB + (size_t)row * RW + c) = pack8(sg); }
            }
        }
    }
};
struct EpiFFN {
    static constexpr bool PERM = true, APERM = true;
    const float* cw; const float* cb; bf16_t* Z; float* HU; const float* ssq;
    __device__ __forceinline__ void operator()(f32x4 (&acc)[2][2][4][2], const Unit& u, int wr, int wc, int fr, int fq) const {
        f32x4 prm[2][8];
#pragma unroll
        for (int n = 0; n < 2; ++n) { const int c = u.pn * 128 + wc * 32 + 8 * fq + 4 * n;
            prm[n][0] = *(const f32x4*)(cw + c); prm[n][1] = *(const f32x4*)(cw + FF2 + c); prm[n][2] = *(const f32x4*)(cw + 2 * FF2 + c); prm[n][3] = *(const f32x4*)(cb + c);
            prm[n][4] = *(const f32x4*)(cw + FF + c); prm[n][5] = *(const f32x4*)(cw + FF2 + FF + c); prm[n][6] = *(const f32x4*)(cw + 2 * FF2 + FF + c); prm[n][7] = *(const f32x4*)(cb + FF + c); }
        if (ssq) { const int rowb = u.pm * 256 + 8 * (16 * wr + fr);
            const f32x4 sA = *(const f32x4*)(ssq + rowb), sB = *(const f32x4*)(ssq + rowb + 4);
            const float sc[8] = {sA[0], sA[1], sA[2], sA[3], sB[0], sB[1], sB[2], sB[3]};
#pragma unroll
            for (int i = 0; i < 8; ++i)
#pragma unroll
                for (int bj = 0; bj < 2; ++bj)
#pragma unroll
                    for (int n = 0; n < 2; ++n) acc[i >> 2][bj][i & 3][n] *= sc[i]; }
        const int rowb = u.pm * 256 + 8 * (16 * wr + fr);
        const int grp = u.pm * 2 + wr, c0 = u.pn * 128 + wc * 32 + 8 * fq;
#define FFN_Z(n, UG, UV, UG1, UV1, UG2, UV2, W0, W1) { const f32x4 cgv = prm[n][3] + prm[n][0] * (UG2) + prm[n][1] * (UG1) + prm[n][2] * (UG), cvv = prm[n][7] + prm[n][4] * (UV2) + prm[n][5] * (UV1) + prm[n][6] * (UV); \
            W0 = cvtpk(cgv[0] * sigmoidf_(cgv[0]) * cvv[0], cgv[1] * sigmoidf_(cgv[1]) * cvv[1]); W1 = cvtpk(cgv[2] * sigmoidf_(cgv[2]) * cvv[2], cgv[3] * sigmoidf_(cgv[3]) * cvv[3]); }
        u32x4 z0, z1;
#define FFN_HEAD(n, A, B) { const int c = c0 + 4 * n; \
            if (fr == 0) { float* h = HU + ((size_t)grp * 4) * FF2; *(f32x4*)(h + c) = acc[0][0][0][n]; *(f32x4*)(h + FF + c) = acc[0][1][0][n]; *(f32x4*)(h + FF2 + c) = acc[0][0][1][n]; *(f32x4*)(h + FF2 + FF + c) = acc[0][1][1][n]; } \
            if (fr == 15) { float* h = HU + ((size_t)grp * 4 + 2) * FF2; *(f32x4*)(h + c) = acc[1][0][2][n]; *(f32x4*)(h + FF + c) = acc[1][1][2][n]; *(f32x4*)(h + FF2 + c) = acc[1][0][3][n]; *(f32x4*)(h + FF2 + FF + c) = acc[1][1][3][n]; } \
            f32x4 pg6, pg7, pv6, pv7; \
            _Pragma("unroll") for (int j = 0; j < 4; ++j) { pg6[j] = dpp_f<0x111>(acc[1][0][2][n][j]); pg7[j] = dpp_f<0x111>(acc[1][0][3][n][j]); pv6[j] = dpp_f<0x111>(acc[1][1][2][n][j]); pv7[j] = dpp_f<0x111>(acc[1][1][3][n][j]); } \
            FFN_Z(n, acc[0][0][0][n], acc[0][1][0][n], pg7, pv7, pg6, pv6, z0.A, z0.B) \
            FFN_Z(n, acc[0][0][1][n], acc[0][1][1][n], acc[0][0][0][n], acc[0][1][0][n], pg7, pv7, z1.A, z1.B) }
        FFN_HEAD(0, x, y) asm volatile("" : "+v"(z0), "+v"(z1) : : "memory"); FFN_HEAD(1, z, w)
        if (fr != 0) { *(u32x4*)(Z + (size_t)(rowb + 0) * FF + c0) = z0; *(u32x4*)(Z + (size_t)(rowb + 1) * FF + c0) = z1; }
#define FFN_ROW16(i, a_, m_, a1_, m1_, a2_, m2_) { u32x4 zz; \
            FFN_Z(0, acc[a_][0][m_][0], acc[a_][1][m_][0], acc[a1_][0][m1_][0], acc[a1_][1][m1_][0], acc[a2_][0][m2_][0], acc[a2_][1][m2_][0], zz.x, zz.y) \
            FFN_Z(1, acc[a_][0][m_][1], acc[a_][1][m_][1], acc[a1_][0][m1_][1], acc[a1_][1][m1_][1], acc[a2_][0][m2_][1], acc[a2_][1][m2_][1], zz.z, zz.w) \
            *(u32x4*)(Z + (size_t)(rowb + (i)) * FF + c0) = zz; }
        asm volatile("" ::: "memory");
        FFN_ROW16(2, 0, 2, 0, 1, 0, 0)
        asm volatile("" ::: "memory");
        FFN_ROW16(3, 0, 3, 0, 2, 0, 1)
        asm volatile("" ::: "memory");
        FFN_ROW16(4, 1, 0, 0, 3, 0, 2)
        asm volatile("" ::: "memory");
        FFN_ROW16(5, 1, 1, 1, 0, 0, 3)
        asm volatile("" ::: "memory");
        FFN_ROW16(6, 1, 2, 1, 1, 1, 0)
        asm volatile("" ::: "memory");
        FFN_ROW16(7, 1, 3, 1, 2, 1, 1)
#undef FFN_ROW16
#undef FFN_HEAD
#undef FFN_Z
    }
};

struct Params { const float* in[31]; float* out; unsigned char* ws; int ph_lo, ph_hi; };
enum { I_X = 0, I_MEM, I_ATTN_NORM, I_A_W_IN, I_A_MU, I_A_W0, I_A_W2, I_A_A0, I_A_A2, I_A_G2, I_A_K_K, I_A_K_A, I_A_R_K, I_A_LNX_W, I_A_LNX_B, I_A_W_OUT,
       I_KV_NORM, I_KV_W, I_KV_K_NORM, I_B_W_IN, I_B_Q_NORM, I_B_W_OUT, I_MEM_NORM, I_MEM_W_KV, I_MEM_Q_NORM, I_MEM_K_NORM, I_FFN_NORM, I_FFN_W_UP, I_FFN_CONV_W, I_FFN_CONV_B, I_FFN_W_DOWN };

__device__ __forceinline__ void tr_item(const float* W, int N, const float* gain, bf16_t* WT, int ldk, int koff, int drow0, int k0, int n0, LAS float* scr, int lane) {
    float wv[32];
#pragma unroll
    for (int i = 0; i < 32; ++i) { const int kk = 2 * i + (lane >> 5); wv[i] = __builtin_nontemporal_load(W + (size_t)(k0 + kk) * N + n0 + (lane & 31)); }
    if (gain) {
#pragma unroll
        for (int i = 0; i < 32; ++i) wv[i] *= gain[k0 + 2 * i + (lane >> 5)]; }
#pragma unroll
    for (int i = 0; i < 32; ++i) { const int kk = 2 * i + (lane >> 5); scr[kk * 33 + (lane & 31)] = wv[i]; }
    asm volatile("s_waitcnt lgkmcnt(0)" ::: "memory");
    const int c = lane & 7;
#pragma unroll
    for (int j = 0; j < 4; ++j) { const int n = (lane >> 3) + 8 * j; const LAS float* s = scr + (8 * c) * 33 + n;
        u32x4 o; o.x = cvtpk(s[0 * 33], s[1 * 33]); o.y = cvtpk(s[2 * 33], s[3 * 33]); o.z = cvtpk(s[4 * 33], s[5 * 33]); o.w = cvtpk(s[6 * 33], s[7 * 33]);
        *(u32x4*)(WT + (size_t)(drow0 + n) * ldk + koff + k0 + 8 * c) = o; }
    asm volatile("s_waitcnt lgkmcnt(0)" ::: "memory");
}
__device__ __forceinline__ void rms_row_to_bf16(const float* xrow, bf16_t* orow, int lane) {
    const f32x4* xr = (const f32x4*)xrow + lane;
    f32x4 v[4]; float s = 0.f;
#pragma unroll
    for (int j = 0; j < 4; ++j) { v[j] = xr[64 * j]; s += (v[j].x * v[j].x + v[j].y * v[j].y) + (v[j].z * v[j].z + v[j].w * v[j].w); }
    const float rs = rsqrtf(wave_sum(s) * (1.f / D) + RMS_EPS);
    u32x2* o8 = (u32x2*)orow + lane;
#pragma unroll
    for (int j = 0; j < 4; ++j) { u32x2 w; w.x = cvtpk(v[j].x * rs, v[j].y * rs); w.y = cvtpk(v[j].z * rs, v[j].w * rs); o8[64 * j] = w; }
}
__device__ __forceinline__ void rms_pass(const float* X, bf16_t* O, int rows, int gw, int ngw, int lane_, float* RSout = nullptr) {
    int lane = lane_; asm volatile("" : "+v"(lane));
    for (int m0 = gw * 4; m0 < rows; m0 += ngw * 4) {
        f32x4 v[4][4]; float s[4];
#pragma unroll
        for (int u = 0; u < 4; ++u) { const f32x4* xr = (const f32x4*)(X + (size_t)(m0 + u) * D) + lane;
#pragma unroll
            for (int j = 0; j < 4; ++j) v[u][j] = __builtin_nontemporal_load(xr + 64 * j); }
#pragma unroll
        for (int u = 0; u < 4; ++u) { s[u] = 0.f;
#pragma unroll
            for (int j = 0; j < 4; ++j) s[u] += (v[u][j].x * v[u][j].x + v[u][j].y * v[u][j].y) + (v[u][j].z * v[u][j].z + v[u][j].w * v[u][j].w); }
#pragma unroll
        for (int o = 1; o < 64; o <<= 1) {
#pragma unroll
            for (int u = 0; u < 4; ++u) s[u] += __shfl_xor(s[u], o); }
#pragma unroll
        for (int u = 0; u < 4; ++u) { float rs = rsqrtf(s[u] * (1.f / D) + RMS_EPS); if (RSout) { if (lane == 0) RSout[m0 + u] = rs; rs = 1.0f; } u32x2* o8 = (u32x2*)(O + (size_t)(m0 + u) * D) + lane;
#pragma unroll
            for (int j = 0; j < 4; ++j) { u32x2 w; w.x = cvtpk(v[u][j].x * rs, v[u][j].y * rs); w.y = cvtpk(v[u][j].z * rs, v[u][j].w * rs); o8[64 * j] = w; } }
    }
}

constexpr int KS_STRIDE = 144, VT_STRIDE = 528, KS_BYTES = 256 * KS_STRIDE, VT_BYTES = 64 * VT_STRIDE;
struct AttnDesc { const bf16_t* Qb; const bf16_t* Kb; const bf16_t* Vb; bf16_t* Ob; float* lse; const float* qgain; const float* kgain; int qpitch, kvpitch, opitch, rho, d, n; };
struct AttnRaw { u32x4 k1a, k2a, k1b, k2b, v0, v1, v2, v3, q1, q2; };
template <bool DIL>
__device__ __forceinline__ void attn_issue(const AttnDesc& a, AttnRaw& R, int tid) {
    const u32x4 z = (u32x4){0u, 0u, 0u, 0u};
#define AT_KLD(it_, K1, K2) do { const int item = tid + 512 * (it_), jj = item >> 2, c = item & 3; const int sub = DIL ? (a.n - 1) * 128 + jj : jj; const int pos = DIL ? a.rho + a.d * sub : jj; \
        K1 = z; K2 = z; if (sub >= 0) { const bf16_t* kp = a.Kb + (size_t)pos * a.kvpitch; K1 = *(const u32x4*)(kp + c * 8); K2 = *(const u32x4*)(kp + 32 + c * 8); } } while (0)
#define AT_VLD(it_, V) do { const int item = tid + 512 * (it_), jj = item >> 3, c = item & 7; const int sub = DIL ? (a.n - 1) * 128 + jj : jj; const int pos = DIL ? a.rho + a.d * sub : jj; \
        V = z; if (sub >= 0) V = *(const u32x4*)(a.Vb + (size_t)pos * a.kvpitch + c * 8); } while (0)
    AT_KLD(0, R.k1a, R.k2a); AT_KLD(1, R.k1b, R.k2b); AT_VLD(0, R.v0); AT_VLD(1, R.v1); AT_VLD(2, R.v2); AT_VLD(3, R.v3);
#undef AT_KLD
#undef AT_VLD
    { const int wave = tid >> 6, lane = tid & 63, iq = 16 * wave + (lane & 15), Q = lane >> 4; const int qpos = DIL ? a.rho + a.d * (a.n * 128 + iq) : a.n * 128 + iq;
      const bf16_t* qp = a.Qb + (size_t)qpos * a.qpitch; R.q1 = *(const u32x4*)(qp + Q * 8); R.q2 = *(const u32x4*)(qp + 32 + Q * 8); }
}
template <bool DIL>
__device__ __forceinline__ void attn_body(LAS unsigned char* lds, const AttnDesc& a, AttnRaw& R, const float* rope, bool has_next, const AttnDesc& nxt) {
    constexpr int NT = DIL ? 10 : 16;
    int tid = threadIdx.x; asm volatile("" : "+v"(tid));
    const int wave = tid >> 6, lane = tid & 63, lr = lane & 15, Q = lane >> 4;
    const int rho = a.rho, d = a.d, n = a.n; const float* kgain = a.kgain; const float* qgain = a.qgain;
    LAS unsigned char* Ks = lds; LAS unsigned char* Vt = lds + KS_BYTES;
#define AT_KST(it_, K1, K2) do { const int item = tid + 512 * (it_), jj = item >> 2, c = item & 3; \
        const int sub = DIL ? (n - 1) * 128 + jj : jj; const bool valid = sub >= 0; const int pos = DIL ? rho + d * sub : jj; \
        float x1[8], x2[8]; unpack8(K1, x1); unpack8(K2, x2); \
        float ss = 0.f; \
        _Pragma("unroll") for (int i = 0; i < 8; ++i) ss += x1[i] * x1[i] + x2[i] * x2[i]; \
        ss += __shfl_xor(ss, 1); ss += __shfl_xor(ss, 2); \
        const float rs = rsqrtf(ss * (1.f / 64.f) + RMS_EPS); \
        float o1[8], o2[8], g1[8], g2[8], cs[8], sn[8]; \
        *(f32x4*)g1 = *(const f32x4*)(kgain + c * 8); *(f32x4*)(g1 + 4) = *(const f32x4*)(kgain + c * 8 + 4); *(f32x4*)g2 = *(const f32x4*)(kgain + 32 + c * 8); *(f32x4*)(g2 + 4) = *(const f32x4*)(kgain + 32 + c * 8 + 4); \
        if (DIL) { const int pz = valid ? pos : 0; *(f32x4*)cs = *(const f32x4*)(rope + pz * 32 + c * 8); *(f32x4*)(cs + 4) = *(const f32x4*)(rope + pz * 32 + c * 8 + 4); \
            *(f32x4*)sn = *(const f32x4*)(rope + T * 32 + pz * 32 + c * 8); *(f32x4*)(sn + 4) = *(const f32x4*)(rope + T * 32 + pz * 32 + c * 8 + 4); } \
        _Pragma("unroll") for (int i = 0; i < 8; ++i) { const float aa = x1[i] * rs * g1[i], bb = x2[i] * rs * g2[i]; \
            if (DIL) { o1[i] = aa * cs[i] - bb * sn[i]; o2[i] = bb * cs[i] + aa * sn[i]; } else { o1[i] = aa; o2[i] = bb; } } \
        *(LAS u32x4*)(Ks + jj * KS_STRIDE + c * 16) = pack8(o1); *(LAS u32x4*)(Ks + jj * KS_STRIDE + 64 + c * 16) = pack8(o2); } while (0)
    AT_KST(0, R.k1a, R.k2a); AT_KST(1, R.k1b, R.k2b);
#undef AT_KST
#define AT_VST(it_, V) do { const int item = tid + 512 * (it_), jj = item >> 3, c = item & 7; const unsigned ww[4] = {V.x, V.y, V.z, V.w}; \
        _Pragma("unroll") for (int i = 0; i < 4; ++i) { *(LAS unsigned short*)(Vt + (c * 8 + 2 * i) * VT_STRIDE + jj * 2) = (unsigned short)(ww[i] & 0xffffu); *(LAS unsigned short*)(Vt + (c * 8 + 2 * i + 1) * VT_STRIDE + jj * 2) = (unsigned short)(ww[i] >> 16); } } while (0)
    AT_VST(0, R.v0); AT_VST(1, R.v1); AT_VST(2, R.v2); AT_VST(3, R.v3);
#undef AT_VST
    constexpr int NQ = DIL ? 1 : 4;
    const int iq = 16 * wave + lr;
    bf16_t* Ob = a.Ob; const int opitch = a.opitch; float* lse = a.lse;
    for (int nn = 0; nn < NQ; ++nn) {
    const int qpos = DIL ? rho + d * (n * 128 + iq) : (n + nn) * 128 + iq;
    bf16x8 bq1, bq2;
    { float x1[8], x2[8]; unpack8(R.q1, x1); unpack8(R.q2, x2);
      float ss = 0.f;
#pragma unroll
      for (int i = 0; i < 8; ++i) ss += x1[i] * x1[i] + x2[i] * x2[i];
      ss += __shfl_xor(ss, 16); ss += __shfl_xor(ss, 32);
      const float rs = rsqrtf(ss * (1.f / 64.f) + RMS_EPS);
      float o1[8], o2[8], g1[8], g2[8], cs[8], sn[8];
      *(f32x4*)g1 = *(const f32x4*)(qgain + Q * 8); *(f32x4*)(g1 + 4) = *(const f32x4*)(qgain + Q * 8 + 4); *(f32x4*)g2 = *(const f32x4*)(qgain + 32 + Q * 8); *(f32x4*)(g2 + 4) = *(const f32x4*)(qgain + 32 + Q * 8 + 4);
      if (DIL) { *(f32x4*)cs = *(const f32x4*)(rope + qpos * 32 + Q * 8); *(f32x4*)(cs + 4) = *(const f32x4*)(rope + qpos * 32 + Q * 8 + 4);
          *(f32x4*)sn = *(const f32x4*)(rope + T * 32 + qpos * 32 + Q * 8); *(f32x4*)(sn + 4) = *(const f32x4*)(rope + T * 32 + qpos * 32 + Q * 8 + 4); }
#pragma unroll
      for (int i = 0; i < 8; ++i) { const float aa = x1[i] * rs * g1[i], bb = x2[i] * rs * g2[i];
          if (DIL) { o1[i] = (aa * cs[i] - bb * sn[i]) * 0.125f; o2[i] = (bb * cs[i] + aa * sn[i]) * 0.125f; }
          else { o1[i] = aa * 0.125f; o2[i] = bb * 0.125f; } }
      bq1 = __builtin_bit_cast(bf16x8, pack8(o1)); bq2 = __builtin_bit_cast(bf16x8, pack8(o2)); }
    if (nn == 0) { asm volatile("s_waitcnt lgkmcnt(0)" ::: "memory"); __builtin_amdgcn_s_barrier(); asm volatile("" ::: "memory"); }
    if (nn + 1 < NQ) { const bf16_t* qp = a.Qb + (size_t)(qpos + 128) * a.qpitch; R.q1 = *(const u32x4*)(qp + Q * 8); R.q2 = *(const u32x4*)(qp + 32 + Q * 8); }
    else if (has_next) attn_issue<DIL>(nxt, R, tid);
    const int kt0 = DIL ? (wave < 6 ? wave : 6) : 0;
    f32x4 s[NT];
#pragma unroll
    for (int kt = 0; kt < NT; ++kt) { const LAS unsigned char* kp = Ks + (16 * (kt0 + kt) + lr) * KS_STRIDE + Q * 16;
        const bf16x8 a1 = *(const LAS bf16x8*)kp, a2 = *(const LAS bf16x8*)(kp + 64);
        f32x4 z = (f32x4){0.f, 0.f, 0.f, 0.f};
        z = __builtin_amdgcn_mfma_f32_16x16x32_bf16(a1, bq1, z, 0, 0, 0); s[kt] = __builtin_amdgcn_mfma_f32_16x16x32_bf16(a2, bq2, z, 0, 0, 0); }
    float mx = -3.0e38f;
#pragma unroll
    for (int kt = 0; kt < NT; ++kt)
#pragma unroll
        for (int j = 0; j < 4; ++j) { if (DIL) { const int jj = 16 * (kt0 + kt) + 4 * Q + j; const bool ok = (jj >= iq) && (jj <= iq + 128) && (n > 0 || jj >= 128); if (!ok) s[kt][j] = -1e30f; } mx = fmaxf(mx, s[kt][j]); }
    mx = fmaxf(mx, __shfl_xor(mx, 16)); mx = fmaxf(mx, __shfl_xor(mx, 32));
    float den = 0.f;
#pragma unroll
    for (int kt = 0; kt < NT; ++kt)
#pragma unroll
        for (int j = 0; j < 4; ++j) { const float e = __expf(s[kt][j] - mx); s[kt][j] = e; den += e; }
    den += __shfl_xor(den, 16); den += __shfl_xor(den, 32);
    f32x4 o[4];
#pragma unroll
    for (int dt = 0; dt < 4; ++dt) o[dt] = (f32x4){0.f, 0.f, 0.f, 0.f};
#pragma unroll
    for (int p2 = 0; p2 < NT / 2; ++p2) {
        u32x4 pb; pb.x = cvtpk(s[2 * p2][0], s[2 * p2][1]); pb.y = cvtpk(s[2 * p2][2], s[2 * p2][3]); pb.z = cvtpk(s[2 * p2 + 1][0], s[2 * p2 + 1][1]); pb.w = cvtpk(s[2 * p2 + 1][2], s[2 * p2 + 1][3]);
        const bf16x8 b = __builtin_bit_cast(bf16x8, pb);
#pragma unroll
        for (int dt = 0; dt < 4; ++dt) { const LAS unsigned char* vp = Vt + (16 * dt + lr) * VT_STRIDE + (16 * (kt0 + 2 * p2) + 4 * Q) * 2;
            const u32x2 lo = *(const LAS u32x2*)vp, hi = *(const LAS u32x2*)(vp + 32);
            const u32x4 av = (u32x4){lo.x, lo.y, hi.x, hi.y};
            o[dt] = __builtin_amdgcn_mfma_f32_16x16x32_bf16(__builtin_bit_cast(bf16x8, av), b, o[dt], 0, 0, 0); }
    }
    const float inv = __builtin_amdgcn_rcpf(den);
    bf16_t* op = Ob + (size_t)qpos * opitch;
#pragma unroll
    for (int dt = 0; dt < 4; ++dt) { u32x2 w; w.x = cvtpk(o[dt][0] * inv, o[dt][1] * inv); w.y = cvtpk(o[dt][2] * inv, o[dt][3] * inv); *(u32x2*)(op + 16 * dt + 4 * Q) = w; }
    if (DIL && Q == 0) lse[(size_t)qpos * 4] = mx + __logf(den);
    }
    asm volatile("s_waitcnt lgkmcnt(0)" ::: "memory"); __builtin_amdgcn_s_barrier(); asm volatile("" ::: "memory");
}

constexpr int TC = 32;
__device__ __forceinline__ float red16(float x) { x += dpp_f<0xB1>(x); x += dpp_f<0x4E>(x); x += dpp_f<0x141>(x); x += dpp_f<0x140>(x); return x; }
struct ScanOps { f32x4 kk, w, ka, k, r; float v; };
__device__ __forceinline__ float h2f(unsigned short h) { return (float)__builtin_bit_cast(_Float16, h); }
__device__ __forceinline__ void scan_half(LAS unsigned char* lds, int hb, const bf16_t* P, const unsigned short* WL, const bf16_t* AB, const bf16_t* KKb,
                                          const float* mu, const float* k_a, const float* r_k, float* RK, bf16_t* Y) {
    int tid = threadIdx.x; asm volatile("" : "+v"(tid));
    const int wave = __builtin_amdgcn_readfirstlane(tid >> 6), lane = tid & 63;
    const int hh = hb >> 1, half = hb & 1, b = hh / 12, h = hh % 12;
    const size_t tok0 = (size_t)b * T;
    LAS float* bufs = (LAS float*)lds;
    LAS float* vbuf = (LAS float*)(lds + 81920 + 1024);
    LAS float* ys = (LAS float*)(lds + 81920 + 1024 + 8192 + 1024);
    constexpr int NCH = T / TC;
    const int sel = tid >> 8, li = tid & 255, lrow = li >> 3, c8 = (li & 7) * 8, ch = h * 64 + c8;
    const int lrv = (li >> 2) & 31, cv = 1536 + h * 64 + 32 * half + (li & 3) * 8;
    float m0[8], m1[8], ka8[8], rk8[8];
    { const float* pa = sel ? mu + cv : mu + ch; *(f32x4*)m0 = *(const f32x4*)pa; *(f32x4*)(m0 + 4) = *(const f32x4*)(pa + 4); }
    *(f32x4*)m1 = *(const f32x4*)(mu + RW + ch); *(f32x4*)(m1 + 4) = *(const f32x4*)(mu + RW + ch + 4);
    *(f32x4*)ka8 = *(const f32x4*)(k_a + ch); *(f32x4*)(ka8 + 4) = *(const f32x4*)(k_a + ch + 4);
    *(f32x4*)rk8 = *(const f32x4*)(r_k + ch); *(f32x4*)(rk8 + 4) = *(const f32x4*)(r_k + ch + 4);
    u32x4 q0, q1, q2, q3, q4, q5;
    const bool vthr = (sel == 1) && (li < 128);
#define SCAN_ISSUE(cc_) do { const size_t tok = tok0 + (size_t)(cc_) * TC + lrow; const size_t tokp = ((cc_) == 0 && lrow == 0) ? tok : tok - 1; \
        if (sel == 0) { q0 = *(const u32x4*)(P + tok * AIN + ch); q1 = *(const u32x4*)(P + tokp * AIN + ch); q2 = *(const u32x4*)(P + tok * AIN + RW + ch); q3 = *(const u32x4*)(P + tokp * AIN + RW + ch); \
            q4 = *(const u32x4*)(AB + tok * RW + ch); q5 = *(const u32x4*)(KKb + tok * RW + ch); } \
        else { q0 = *(const u32x4*)(WL + tok * RW + ch); \
            if (vthr) { const size_t tv = tok0 + (size_t)(cc_) * TC + lrv; const size_t tvp = ((cc_) == 0 && lrv == 0) ? tv : tv - 1; q1 = *(const u32x4*)(P + tv * AIN + cv); q2 = *(const u32x4*)(P + tvp * AIN + cv); } } } while (0)
#define ST8(dst, a) do { *(LAS f32x4*)(dst) = (f32x4){a[0], a[1], a[2], a[3]}; *(LAS f32x4*)((dst) + 4) = (f32x4){a[4], a[5], a[6], a[7]}; } while (0)
#define SCAN_COMMIT(cc_) do { LAS float* bb_ = bufs + ((cc_) & 1) * 5 * (TC * 64) + lrow * 64 + c8; \
        if (sel == 0) { const bool z_ = ((cc_) == 0 && lrow == 0); float pc[8], pp[8], rr[8], kr[8], av[8], kk[8], o[8]; \
            unpack8(q0, pc); unpack8(q1, pp); \
            _Pragma("unroll") for (int j = 0; j < 8; ++j) { const float pv = z_ ? 0.f : pp[j]; rr[j] = pc[j] + (pv - pc[j]) * m0[j]; } \
            ST8(bb_, rr); \
            unpack8(q2, pc); unpack8(q3, pp); unpack8(q4, av); unpack8(q5, kk); \
            float rks = 0.f; \
            _Pragma("unroll") for (int j = 0; j < 8; ++j) { const float pv = z_ ? 0.f : pp[j]; const float kx = pc[j] + (pv - pc[j]) * m1[j]; kr[j] = kx * (1.0f + (av[j] - 1.0f) * ka8[j]); o[j] = kk[j] * av[j]; rks += rr[j] * kr[j] * rk8[j]; } \
            ST8(bb_ + 2 * TC * 64, kr); ST8(bb_ + 3 * TC * 64, kk); ST8(bb_ + 4 * TC * 64, o); \
            rks = red8(rks); \
            if (half == 0 && (li & 7) == 0) RK[(tok0 + (size_t)(cc_) * TC + lrow) * 12 + h] = rks; \
        } else { float o[8]; \
            o[0] = __expf(h2f((unsigned short)(q0.x & 0xffffu))); o[1] = __expf(h2f((unsigned short)(q0.x >> 16))); o[2] = __expf(h2f((unsigned short)(q0.y & 0xffffu))); o[3] = __expf(h2f((unsigned short)(q0.y >> 16))); \
            o[4] = __expf(h2f((unsigned short)(q0.z & 0xffffu))); o[5] = __expf(h2f((unsigned short)(q0.z >> 16))); o[6] = __expf(h2f((unsigned short)(q0.w & 0xffffu))); o[7] = __expf(h2f((unsigned short)(q0.w >> 16))); \
            ST8(bb_ + 1 * TC * 64, o); \
            if (vthr) { const bool zv_ = ((cc_) == 0 && lrv == 0); float pc[8], pp[8]; unpack8(q1, pc); unpack8(q2, pp); \
                _Pragma("unroll") for (int j = 0; j < 8; ++j) { const float pv = zv_ ? 0.f : pp[j]; o[j] = pc[j] + (pv - pc[j]) * m0[j]; } \
                LAS float* vb_ = vbuf + ((cc_) & 1) * TC * 32 + lrv * 32 + (li & 3) * 8; ST8(vb_, o); } } } while (0)
    const int rg = lane >> 4, kl = lane & 15, row32 = wave * 4 + rg;
    f32x4 S = (f32x4){0.f, 0.f, 0.f, 0.f};
    SCAN_ISSUE(0); SCAN_COMMIT(0); __syncthreads();
    for (int chunk = 0; chunk < NCH; ++chunk) {
        if (chunk + 1 < NCH) SCAN_ISSUE(chunk + 1);
        const LAS float* bb = bufs + (chunk & 1) * 5 * TC * 64 + kl * 4;
        const LAS float* vb = vbuf + (chunk & 1) * TC * 32 + row32;
#define SCAN_LD(X, t) do { const LAS float* q_ = bb + (t) * 64; X.kk = *(const LAS f32x4*)(q_ + 3 * TC * 64); X.w = *(const LAS f32x4*)(q_ + 1 * TC * 64); X.ka = *(const LAS f32x4*)(q_ + 4 * TC * 64); \
            X.k = *(const LAS f32x4*)(q_ + 2 * TC * 64); X.r = *(const LAS f32x4*)(q_); X.v = vb[(t) * 32]; } while (0)
#define SCAN_STEP(X, yout) do { const f32x4 pa_ = S * X.kk; const f32x2 pq_ = pa_.xy + pa_.zw; float sa_ = pq_.x + pq_.y; sa_ = -red16(sa_); \
            S = S * X.w + (X.ka * sa_ + X.k * X.v); \
            const f32x4 py_ = S * X.r; const f32x2 pr_ = py_.xy + py_.zw; const float y_ = pr_.x + pr_.y; yout = red16(y_); } while (0)
        ScanOps X0, X1;
        SCAN_LD(X0, 0);
        for (int t = 0; t < TC; t += 2) {
            float y0, y1;
            SCAN_LD(X1, t + 1);
            SCAN_STEP(X0, y0);
            SCAN_LD(X0, t + 2);
            SCAN_STEP(X1, y1);
            if (kl == 0) { ys[t * 32 + row32] = y0; ys[(t + 1) * 32 + row32] = y1; }
        }
#undef SCAN_LD
#undef SCAN_STEP
        __syncthreads();
        {
            const int t = tid >> 4, r2 = (tid & 15) * 2;
            const f32x2 yv = *(const LAS f32x2*)(ys + t * 32 + r2);
            *(unsigned*)(Y + (tok0 + (size_t)chunk * TC + t) * D + h * 64 + 32 * half + r2) = cvtpk(yv[0], yv[1]);
        }
        if (chunk + 1 < NCH) SCAN_COMMIT(chunk + 1);
        __syncthreads();
    }
#undef SCAN_ISSUE
#undef SCAN_COMMIT
#undef ST8
}

constexpr int CH = 16, WINCH = 32, NWIN = (T / CH) / WINCH;
constexpr int CK_AT = 0, CK_RT = 2048, CK_KB = 4096, CK_VF = 8192, CK_G1 = 10240, CK_G2 = 10752, CK_G3 = 11264, CK_W = 12288, CK_BYTES = 12544;
constexpr int PREP_LDS = 14336;
struct PrepRaw { u32x4 q[2][9]; };
__device__ __forceinline__ void rwkv_prep_issue(PrepRaw& R, int hh, int c, const bf16_t* P, const unsigned short* WL, const bf16_t* AB, const bf16_t* KKb, int lane) {
    const int b = hh / 12, h = hh % 12; const size_t tok0 = (size_t)b * T + (size_t)c * CH; const int chn = h * 64 + (lane & 7) * 8;
#pragma unroll
    for (int i = 0; i < 2; ++i) { const int row = (lane >> 3) + 8 * i; const size_t tok = tok0 + row; const size_t tokp = (c == 0 && row == 0) ? tok : tok - 1;
        R.q[i][0] = *(const u32x4*)(P + tok * AIN + chn); R.q[i][1] = *(const u32x4*)(P + tokp * AIN + chn);
        R.q[i][2] = *(const u32x4*)(P + tok * AIN + RW + chn); R.q[i][3] = *(const u32x4*)(P + tokp * AIN + RW + chn);
        R.q[i][4] = *(const u32x4*)(P + tok * AIN + 1536 + chn); R.q[i][5] = *(const u32x4*)(P + tokp * AIN + 1536 + chn);
        R.q[i][6] = *(const u32x4*)(AB + tok * RW + chn); R.q[i][7] = *(const u32x4*)(KKb + tok * RW + chn); R.q[i][8] = *(const u32x4*)(WL + tok * RW + chn); }
}
__device__ __forceinline__ void rwkv_prep_compute(LAS unsigned char* L, int hh, int c, unsigned char* rec, PrepRaw& R, const bf16_t* P, const unsigned short* WL, const bf16_t* AB, const bf16_t* KKb,
                                                  const float* mu, const float* k_a, const float* r_k, float* RK, int lane, bool has_next, int hh_n, int c_n) {
    const int b = hh / 12, h = hh % 12; const size_t tok0 = (size_t)b * T + (size_t)c * CH;
    LAS float* Wf = (LAS float*)L;
    LAS bf16_t* tKK = (LAS bf16_t*)(L + 4096); LAS bf16_t* tR = (LAS bf16_t*)(L + 6144); LAS bf16_t* tKM = (LAS bf16_t*)(L + 8192); LAS bf16_t* tB = (LAS bf16_t*)(L + 10240); LAS bf16_t* tV = (LAS bf16_t*)(L + 12288);
    const int lr = lane & 15, Q = lane >> 4;
    {
        const int c8 = (lane & 7) * 8, chn = h * 64 + c8;
        float mr[8], mk[8], mv[8], ka8[8], rk8[8];
        *(f32x4*)mr = *(const f32x4*)(mu + chn); *(f32x4*)(mr + 4) = *(const f32x4*)(mu + chn + 4);
        *(f32x4*)mk = *(const f32x4*)(mu + RW + chn); *(f32x4*)(mk + 4) = *(const f32x4*)(mu + RW + chn + 4);
        *(f32x4*)mv = *(const f32x4*)(mu + 1536 + chn); *(f32x4*)(mv + 4) = *(const f32x4*)(mu + 1536 + chn + 4);
        *(f32x4*)ka8 = *(const f32x4*)(k_a + chn); *(f32x4*)(ka8 + 4) = *(const f32x4*)(k_a + chn + 4);
        *(f32x4*)rk8 = *(const f32x4*)(r_k + chn); *(f32x4*)(rk8 + 4) = *(const f32x4*)(r_k + chn + 4);
#pragma unroll
        for (int i = 0; i < 2; ++i) {
            const int row = (lane >> 3) + 8 * i; const size_t tok = tok0 + row; const bool z = (c == 0 && row == 0);
            const u32x4 qr = R.q[i][0], qrp = R.q[i][1], qk = R.q[i][2], qkp = R.q[i][3], qv = R.q[i][4], qvp = R.q[i][5], qa = R.q[i][6], qkk = R.q[i][7], qw = R.q[i][8];
            float pc[8], pp[8], rr[8], km[8], vv[8], av[8], kk[8], bb[8], ww[8];
            unpack8(qr, pc); unpack8(qrp, pp);
#pragma unroll
            for (int j = 0; j < 8; ++j) { const float pv = z ? 0.f : pp[j]; rr[j] = pc[j] + (pv - pc[j]) * mr[j]; }
            unpack8(qk, pc); unpack8(qkp, pp); unpack8(qa, av); unpack8(qkk, kk);
            float rks = 0.f;
#pragma unroll
            for (int j = 0; j < 8; ++j) { const float pv = z ? 0.f : pp[j]; const float kx = pc[j] + (pv - pc[j]) * mk[j]; km[j] = kx * (1.0f + (av[j] - 1.0f) * ka8[j]); bb[j] = kk[j] * av[j]; rks += rr[j] * km[j] * rk8[j]; }
            unpack8(qv, pc); unpack8(qvp, pp);
#pragma unroll
            for (int j = 0; j < 8; ++j) { const float pv = z ? 0.f : pp[j]; vv[j] = pc[j] + (pv - pc[j]) * mv[j]; }
            rks = red8(rks);
            if ((lane & 7) == 0) RK[tok * 12 + h] = rks;
            ww[0] = __expf(h2f((unsigned short)(qw.x & 0xffffu))); ww[1] = __expf(h2f((unsigned short)(qw.x >> 16))); ww[2] = __expf(h2f((unsigned short)(qw.y & 0xffffu))); ww[3] = __expf(h2f((unsigned short)(qw.y >> 16)));
            ww[4] = __expf(h2f((unsigned short)(qw.z & 0xffffu))); ww[5] = __expf(h2f((unsigned short)(qw.z >> 16))); ww[6] = __expf(h2f((unsigned short)(qw.w & 0xffffu))); ww[7] = __expf(h2f((unsigned short)(qw.w >> 16)));
            *(LAS f32x4*)(Wf + row * 64 + c8) = (f32x4){ww[0], ww[1], ww[2], ww[3]}; *(LAS f32x4*)(Wf + row * 64 + c8 + 4) = (f32x4){ww[4], ww[5], ww[6], ww[7]};
            *(LAS u32x4*)(tKK + row * 64 + c8) = pack8(kk); *(LAS u32x4*)(tR + row * 64 + c8) = pack8(rr); *(LAS u32x4*)(tKM + row * 64 + c8) = pack8(km);
            *(LAS u32x4*)(tB + row * 64 + c8) = pack8(bb); *(LAS u32x4*)(tV + row * 64 + c8) = pack8(vv);
        }
    }
    if (has_next) rwkv_prep_issue(R, hh_n, c_n, P, WL, AB, KKb, lane);
    asm volatile("s_waitcnt lgkmcnt(0)" ::: "memory");
    {
        const int cp = lane & 31, hf = lane >> 5;
        float wl0[8], wl1[8]; float a0 = 1.0f, a1 = 1.0f;
#pragma unroll
        for (int tt = 0; tt < 8; ++tt) { const f32x2 w2 = *(const LAS f32x2*)(Wf + (8 * hf + tt) * 64 + 2 * cp); a0 *= w2.x; a1 *= w2.y; wl0[tt] = a0; wl1[tt] = a1; }
        asm volatile("s_waitcnt lgkmcnt(0)" ::: "memory");
        if (hf == 0) *(LAS f32x2*)(Wf + 2 * cp) = (f32x2){a0, a1};
        asm volatile("s_waitcnt lgkmcnt(0)" ::: "memory");
        f32x2 bs = (f32x2){1.0f, 1.0f};
        if (hf == 1) bs = *(const LAS f32x2*)(Wf + 2 * cp);
        float kap0[8], kap1[8], bet0[8], bet1[8]; unsigned vraw[8];
#pragma unroll
        for (int tt = 0; tt < 8; ++tt) {
            const int t = 8 * hf + tt;
            const float W0 = bs.x * wl0[tt], W1 = bs.y * wl1[tt]; const float P0 = (tt == 0) ? bs.x : bs.x * wl0[tt > 0 ? tt - 1 : 0], P1 = (tt == 0) ? bs.y : bs.y * wl1[tt > 0 ? tt - 1 : 0];
            const float i0 = __builtin_amdgcn_rcpf(W0), i1 = __builtin_amdgcn_rcpf(W1);
            const unsigned qkk = *(const LAS unsigned*)(tKK + t * 64 + 2 * cp), qr = *(const LAS unsigned*)(tR + t * 64 + 2 * cp), qkm = *(const LAS unsigned*)(tKM + t * 64 + 2 * cp), qb = *(const LAS unsigned*)(tB + t * 64 + 2 * cp);
            vraw[tt] = *(const LAS unsigned*)(tV + t * 64 + 2 * cp);
            kap0[tt] = bflo(qkm) * i0; kap1[tt] = bfhi(qkm) * i1; bet0[tt] = bflo(qb) * i0; bet1[tt] = bfhi(qb) * i1;
            *(LAS unsigned*)(tKK + t * 64 + 2 * cp) = cvtpk(P0 * bflo(qkk), P1 * bfhi(qkk)); *(LAS unsigned*)(tR + t * 64 + 2 * cp) = cvtpk(W0 * bflo(qr), W1 * bfhi(qr));
            *(LAS unsigned*)(tKM + t * 64 + 2 * cp) = cvtpk(kap0[tt], kap1[tt]); *(LAS unsigned*)(tB + t * 64 + 2 * cp) = cvtpk(bet0[tt], bet1[tt]);
        }
        u32x4* kbp = (u32x4*)(rec + CK_KB); u32x2* vfp = (u32x2*)(rec + CK_VF);
        const int k0 = 2 * cp, kt0 = k0 >> 4, r0 = k0 & 15;
#pragma unroll
        for (int q = 0; q < 2; ++q) { const int Qp = 2 * hf + q;
            u32x4 wa; wa.x = cvtpk(kap0[4 * q], kap0[4 * q + 1]); wa.y = cvtpk(kap0[4 * q + 2], kap0[4 * q + 3]); wa.z = cvtpk(-bet0[4 * q], -bet0[4 * q + 1]); wa.w = cvtpk(-bet0[4 * q + 2], -bet0[4 * q + 3]);
            u32x4 wb; wb.x = cvtpk(kap1[4 * q], kap1[4 * q + 1]); wb.y = cvtpk(kap1[4 * q + 2], kap1[4 * q + 3]); wb.z = cvtpk(-bet1[4 * q], -bet1[4 * q + 1]); wb.w = cvtpk(-bet1[4 * q + 2], -bet1[4 * q + 3]);
            kbp[(kt0 * 4 + Qp) * 16 + r0] = wa; kbp[(kt0 * 4 + Qp) * 16 + r0 + 1] = wb;
            u32x2 va; va.x = (vraw[4 * q] & 0xffffu) | (vraw[4 * q + 1] << 16); va.y = (vraw[4 * q + 2] & 0xffffu) | (vraw[4 * q + 3] << 16);
            u32x2 vb; vb.x = (vraw[4 * q] >> 16) | (vraw[4 * q + 1] & 0xffff0000u); vb.y = (vraw[4 * q + 2] >> 16) | (vraw[4 * q + 3] & 0xffff0000u);
            vfp[(kt0 * 4 + Qp) * 16 + r0] = va; vfp[(kt0 * 4 + Qp) * 16 + r0 + 1] = vb; }
        if (hf == 1) *(f32x2*)((float*)(rec + CK_W) + 2 * cp) = (f32x2){bs.x * wl0[7], bs.y * wl1[7]};
    }
    asm volatile("s_waitcnt lgkmcnt(0)" ::: "memory");
    {
        bf16x8 aB[2], aK[2], bA[2], bR[2];
#pragma unroll
        for (int p = 0; p < 2; ++p) { const int o = lr * 64 + 32 * p + 8 * Q;
            aB[p] = *(const LAS bf16x8*)(tB + o); aK[p] = *(const LAS bf16x8*)(tKM + o); bA[p] = *(const LAS bf16x8*)(tKK + o); bR[p] = *(const LAS bf16x8*)(tR + o); }
        const f32x4 z4 = (f32x4){0.f, 0.f, 0.f, 0.f};
        f32x4 Nb = __builtin_amdgcn_mfma_f32_16x16x32_bf16(aB[0], bA[0], z4, 0, 0, 0); Nb = __builtin_amdgcn_mfma_f32_16x16x32_bf16(aB[1], bA[1], Nb, 0, 0, 0);
        f32x4 Nk = __builtin_amdgcn_mfma_f32_16x16x32_bf16(aK[0], bA[0], z4, 0, 0, 0); Nk = __builtin_amdgcn_mfma_f32_16x16x32_bf16(aK[1], bA[1], Nk, 0, 0, 0);
        f32x4 Mk = __builtin_amdgcn_mfma_f32_16x16x32_bf16(aK[0], bR[0], z4, 0, 0, 0); Mk = __builtin_amdgcn_mfma_f32_16x16x32_bf16(aK[1], bR[1], Mk, 0, 0, 0);
        f32x4 Mb = __builtin_amdgcn_mfma_f32_16x16x32_bf16(aB[0], bR[0], z4, 0, 0, 0); Mb = __builtin_amdgcn_mfma_f32_16x16x32_bf16(aB[1], bR[1], Mb, 0, 0, 0);
#pragma unroll
        for (int r = 0; r < 4; ++r) { const int j = 4 * Q + r; if (!(j < lr)) { Nb[r] = 0.f; Nk[r] = 0.f; } if (!(j <= lr)) { Mk[r] = 0.f; Mb[r] = 0.f; } }
        u32x2 g1; g1.x = cvtpk(Nk[0], Nk[1]); g1.y = cvtpk(Nk[2], Nk[3]); ((u32x2*)(rec + CK_G1))[lane] = g1;
        u32x4 g3; g3.x = cvtpk(Mk[0], Mk[1]); g3.y = cvtpk(Mk[2], Mk[3]); g3.z = cvtpk(-Mb[0], -Mb[1]); g3.w = cvtpk(-Mb[2], -Mb[3]); ((u32x4*)(rec + CK_G3))[lane] = g3;
        *(LAS f32x4*)(Wf + lr * 16 + 4 * Q) = Nb;
    }
    asm volatile("s_waitcnt lgkmcnt(0)" ::: "memory");
    {
        float Tr[16];
#pragma unroll
        for (int t = 0; t < 16; ++t) {
            const f32x4 zz = (f32x4){0.f, 0.f, 0.f, 0.f};
            const f32x4 n0 = (t > 0) ? *(const LAS f32x4*)(Wf + t * 16) : zz, n1 = (t > 4) ? *(const LAS f32x4*)(Wf + t * 16 + 4) : zz, n2 = (t > 8) ? *(const LAS f32x4*)(Wf + t * 16 + 8) : zz, n3 = (t > 12) ? *(const LAS f32x4*)(Wf + t * 16 + 12) : zz;
            const float nt[16] = {n0[0], n0[1], n0[2], n0[3], n1[0], n1[1], n1[2], n1[3], n2[0], n2[1], n2[2], n2[3], n3[0], n3[1], n3[2], n3[3]};
            float sacc = (t == lr) ? 1.0f : 0.0f;
#pragma unroll
            for (int m = 0; m < t; ++m) sacc -= Tr[m] * nt[m];
            Tr[t] = sacc;
        }
        if (Q == 0) {
#pragma unroll
            for (int q = 0; q < 4; ++q) *(LAS f32x4*)(Wf + 256 + lr * 16 + 4 * q) = (f32x4){Tr[4 * q], Tr[4 * q + 1], Tr[4 * q + 2], Tr[4 * q + 3]}; }
    }
    asm volatile("s_waitcnt lgkmcnt(0)" ::: "memory");
    {
        u32x2 g2; g2.x = cvtpk(Wf[256 + (4 * Q) * 16 + lr], Wf[256 + (4 * Q + 1) * 16 + lr]); g2.y = cvtpk(Wf[256 + (4 * Q + 2) * 16 + lr], Wf[256 + (4 * Q + 3) * 16 + lr]);
        ((u32x2*)(rec + CK_G2))[lane] = g2;
#pragma unroll
        for (int p = 0; p < 2; ++p) { const int o = lr * 64 + 32 * p + 4 * Q;
            const u32x2 alo = *(const LAS u32x2*)(tKK + o), ahi = *(const LAS u32x2*)(tKK + o + 16), rlo = *(const LAS u32x2*)(tR + o), rhi = *(const LAS u32x2*)(tR + o + 16);
            ((u32x4*)(rec + CK_AT))[p * 64 + lane] = (u32x4){alo.x, alo.y, ahi.x, ahi.y}; ((u32x4*)(rec + CK_RT))[p * 64 + lane] = (u32x4){rlo.x, rlo.y, rhi.x, rhi.y}; }
    }
    asm volatile("s_waitcnt lgkmcnt(0)" ::: "memory");
}
__device__ __forceinline__ void rwkv_prep_chunk(LAS unsigned char* L, int hh, int c, unsigned char* rec, const bf16_t* P, const unsigned short* WL, const bf16_t* AB, const bf16_t* KKb,
                                                const float* mu, const float* k_a, const float* r_k, float* RK, int lane) {
    PrepRaw R; rwkv_prep_issue(R, hh, c, P, WL, AB, KKb, lane);
    rwkv_prep_compute(L, hh, c, rec, R, P, WL, AB, KKb, mu, k_a, r_k, RK, lane, false, 0, 0);
}
template <int CTRL> __device__ __forceinline__ float dpp_keep(float old, float x) { return __int_as_float(__builtin_amdgcn_update_dpp(__float_as_int(old), __float_as_int(x), CTRL, 0xf, 0xf, false)); }
__device__ __forceinline__ void rwkv_prep2(LAS unsigned char* L, int hh, int c, unsigned char* rec, const bf16_t* P, const unsigned short* WL, const bf16_t* AB, const float* k_k,
                                           const float* mu, const float* k_a, const float* r_k, float* RK, int lane_) {
    int lane = lane_; asm volatile("" : "+v"(lane));
    const int b = hh / 12, h = hh % 12; const size_t tok0 = (size_t)b * T + (size_t)c * CH;
    LAS float* Wf = (LAS float*)L;
    const int t = lane & 15, cg = lane >> 4, lr = t, Q = cg;
    const int chn = h * 64 + 16 * cg; const size_t tok = tok0 + t;
    bf16x8 bA[2], bR[2], aK[2], aB[2], aV[2];
    float rks = 0.f;
    const bool first = (c == 0);
    float kxs[16]; float knorm;
    { float ss = 0.f;
#pragma unroll
      for (int hf = 0; hf < 2; ++hf) { const int ch = chn + 8 * hf; const unsigned po_ = (unsigned)tok * (unsigned)AIN + (unsigned)ch;
          const u32x4 qk = *(const u32x4*)(P + (po_ + RW)); u32x4 pk_ = (u32x4){0u, 0u, 0u, 0u}; if (t == 0 && !first) pk_ = *(const u32x4*)(P + (po_ - AIN + RW));
          float pc[8], po[8], m8[8], q8[8]; unpack8(qk, pc); unpack8(pk_, po);
          *(f32x4*)m8 = *(const f32x4*)(mu + RW + ch); *(f32x4*)(m8 + 4) = *(const f32x4*)(mu + RW + ch + 4); *(f32x4*)q8 = *(const f32x4*)(k_k + ch); *(f32x4*)(q8 + 4) = *(const f32x4*)(k_k + ch + 4);
#pragma unroll
          for (int j = 0; j < 8; ++j) { const float pv = dpp_keep<0x111>(po[j], pc[j]); const float kx = pc[j] + (pv - pc[j]) * m8[j]; kxs[8 * hf + j] = kx; const float kq = kx * q8[j]; ss += kq * kq; } }
      ss += __shfl_xor(ss, 16); ss += __shfl_xor(ss, 32);
      knorm = 1.0f / fmaxf(sqrtf(ss), 1e-12f); }
#pragma unroll
    for (int hf = 0; hf < 2; ++hf) {
        const int ch = chn + 8 * hf;
        const unsigned po_ = (unsigned)tok * (unsigned)AIN + (unsigned)ch, so_ = (unsigned)tok * (unsigned)RW + (unsigned)ch;
        const u32x4 qr = *(const u32x4*)(P + po_), qv = *(const u32x4*)(P + (po_ + 1536));
        const u32x4 qa = *(const u32x4*)(AB + so_), qw = *(const u32x4*)(WL + so_);
        u32x4 pr_ = (u32x4){0u, 0u, 0u, 0u}, pv_ = pr_;
        if (t == 0 && !first) { pr_ = *(const u32x4*)(P + (po_ - AIN)); pv_ = *(const u32x4*)(P + (po_ - AIN + 1536)); }
        float pc[8], po[8], av[8], rr[8], km[8], bb[8], kk[8], W[8], m8[8], g8[8];
        unpack8(qr, pc); unpack8(pr_, po); *(f32x4*)m8 = *(const f32x4*)(mu + ch); *(f32x4*)(m8 + 4) = *(const f32x4*)(mu + ch + 4);
#pragma unroll
        for (int j = 0; j < 8; ++j) { const float pv = dpp_keep<0x111>(po[j], pc[j]); rr[j] = pc[j] + (pv - pc[j]) * m8[j]; }
        unpack8(qa, av);
        *(f32x4*)m8 = *(const f32x4*)(k_k + ch); *(f32x4*)(m8 + 4) = *(const f32x4*)(k_k + ch + 4); *(f32x4*)g8 = *(const f32x4*)(k_a + ch); *(f32x4*)(g8 + 4) = *(const f32x4*)(k_a + ch + 4);
#pragma unroll
        for (int j = 0; j < 8; ++j) { const float kx = kxs[8 * hf + j]; kk[j] = kx * m8[j] * knorm;
            km[j] = kx * (1.0f + (av[j] - 1.0f) * g8[j]); bb[j] = kk[j] * av[j]; }
        *(f32x4*)g8 = *(const f32x4*)(r_k + ch); *(f32x4*)(g8 + 4) = *(const f32x4*)(r_k + ch + 4);
#pragma unroll
        for (int j = 0; j < 8; ++j) rks += rr[j] * km[j] * g8[j];
        unpack8(qv, pc); unpack8(pv_, po); *(f32x4*)m8 = *(const f32x4*)(mu + 1536 + ch); *(f32x4*)(m8 + 4) = *(const f32x4*)(mu + 1536 + ch + 4);
#pragma unroll
        for (int j = 0; j < 8; ++j) { const float pv = dpp_keep<0x111>(po[j], pc[j]); po[j] = pc[j] + (pv - pc[j]) * m8[j]; }
        aV[hf] = __builtin_bit_cast(bf16x8, pack8(po));
        W[0] = __expf(h2f((unsigned short)(qw.x & 0xffffu))); W[1] = __expf(h2f((unsigned short)(qw.x >> 16))); W[2] = __expf(h2f((unsigned short)(qw.y & 0xffffu))); W[3] = __expf(h2f((unsigned short)(qw.y >> 16)));
        W[4] = __expf(h2f((unsigned short)(qw.z & 0xffffu))); W[5] = __expf(h2f((unsigned short)(qw.z >> 16))); W[6] = __expf(h2f((unsigned short)(qw.w & 0xffffu))); W[7] = __expf(h2f((unsigned short)(qw.w >> 16)));
#pragma unroll
        for (int i = 0; i < 8; ++i) { float w = W[i];
            w *= dpp_keep<0x111>(1.0f, w); w *= dpp_keep<0x112>(1.0f, w); w *= dpp_keep<0x114>(1.0f, w); w *= dpp_keep<0x118>(1.0f, w);
            const float wp = dpp_keep<0x111>(1.0f, w); const float iw = __builtin_amdgcn_rcpf(w);
            W[i] = w; kk[i] *= wp; rr[i] *= w; km[i] *= iw; bb[i] *= iw; }
        bA[hf] = __builtin_bit_cast(bf16x8, pack8(kk)); bR[hf] = __builtin_bit_cast(bf16x8, pack8(rr)); aK[hf] = __builtin_bit_cast(bf16x8, pack8(km)); aB[hf] = __builtin_bit_cast(bf16x8, pack8(bb));
        if (t == 15) { *(f32x4*)((float*)(rec + CK_W) + 16 * (2 * hf) + 4 * cg) = (f32x4){W[0], W[1], W[2], W[3]}; *(f32x4*)((float*)(rec + CK_W) + 16 * (2 * hf + 1) + 4 * cg) = (f32x4){W[4], W[5], W[6], W[7]}; }
        asm volatile("" : "+v"(bA[hf]), "+v"(bR[hf]), "+v"(aK[hf]), "+v"(aB[hf]), "+v"(aV[hf]) : : "memory");
    }
    rks += __shfl_xor(rks, 16); rks += __shfl_xor(rks, 32);
    if (cg == 0) RK[tok * 12 + h] = rks;
    const f32x4 z4 = (f32x4){0.f, 0.f, 0.f, 0.f};
#pragma unroll
    for (int p = 0; p < 2; ++p) { ((u32x4*)(rec + CK_AT))[p * 64 + lane] = __builtin_bit_cast(u32x4, bA[p]); ((u32x4*)(rec + CK_RT))[p * 64 + lane] = __builtin_bit_cast(u32x4, bR[p]); }
    {
        const unsigned one = 0x3F80u; const bool on = (Q == (lr >> 2));
#pragma unroll
        for (int e = 0; e < 2; ++e) { const int slot = 4 * e + (lr & 3); const unsigned val = on ? (one << (16 * (slot & 1))) : 0u; const int wd = slot >> 1;
            const u32x4 selw = (u32x4){wd == 0 ? val : 0u, wd == 1 ? val : 0u, wd == 2 ? val : 0u, wd == 3 ? val : 0u}; const bf16x8 sel = __builtin_bit_cast(bf16x8, selw);
#pragma unroll
            for (int p = 0; p < 2; ++p) { const f32x4 Dk = __builtin_amdgcn_mfma_f32_16x16x32_bf16(aK[p], sel, z4, 0, 0, 0), Db = __builtin_amdgcn_mfma_f32_16x16x32_bf16(aB[p], sel, z4, 0, 0, 0);
                u32x4 w; w.x = cvtpk(Dk[0], Dk[1]); w.y = cvtpk(Dk[2], Dk[3]); w.z = cvtpk(-Db[0], -Db[1]); w.w = cvtpk(-Db[2], -Db[3]);
                ((u32x4*)(rec + CK_KB))[(2 * p + e) * 64 + lane] = w; } }
#pragma unroll
        for (int vt = 0; vt < 4; ++vt) { f32x4 Dv = z4;
#pragma unroll
            for (int p = 0; p < 2; ++p) { const bool onv = (Q == vt) && ((lr >> 3) == p); const int slot = lr & 7; const unsigned val = onv ? (one << (16 * (slot & 1))) : 0u; const int wd = slot >> 1;
                const u32x4 selw = (u32x4){wd == 0 ? val : 0u, wd == 1 ? val : 0u, wd == 2 ? val : 0u, wd == 3 ? val : 0u};
                Dv = __builtin_amdgcn_mfma_f32_16x16x32_bf16(aV[p], __builtin_bit_cast(bf16x8, selw), Dv, 0, 0, 0); }
            u32x2 w; w.x = cvtpk(Dv[0], Dv[1]); w.y = cvtpk(Dv[2], Dv[3]); ((u32x2*)(rec + CK_VF))[vt * 64 + lane] = w; }
    }
    {
        f32x4 Nb = __builtin_amdgcn_mfma_f32_16x16x32_bf16(aB[0], bA[0], z4, 0, 0, 0); Nb = __builtin_amdgcn_mfma_f32_16x16x32_bf16(aB[1], bA[1], Nb, 0, 0, 0);
        f32x4 Nk = __builtin_amdgcn_mfma_f32_16x16x32_bf16(aK[0], bA[0], z4, 0, 0, 0); Nk = __builtin_amdgcn_mfma_f32_16x16x32_bf16(aK[1], bA[1], Nk, 0, 0, 0);
        f32x4 Mk = __builtin_amdgcn_mfma_f32_16x16x32_bf16(aK[0], bR[0], z4, 0, 0, 0); Mk = __builtin_amdgcn_mfma_f32_16x16x32_bf16(aK[1], bR[1], Mk, 0, 0, 0);
        f32x4 Mb = __builtin_amdgcn_mfma_f32_16x16x32_bf16(aB[0], bR[0], z4, 0, 0, 0); Mb = __builtin_amdgcn_mfma_f32_16x16x32_bf16(aB[1], bR[1], Mb, 0, 0, 0);
#pragma unroll
        for (int r = 0; r < 4; ++r) { const int j = 4 * Q + r; if (!(j < lr)) { Nb[r] = 0.f; Nk[r] = 0.f; } if (!(j <= lr)) { Mk[r] = 0.f; Mb[r] = 0.f; } }
        u32x2 g1; g1.x = cvtpk(Nk[0], Nk[1]); g1.y = cvtpk(Nk[2], Nk[3]); ((u32x2*)(rec + CK_G1))[lane] = g1;
        u32x4 g3; g3.x = cvtpk(Mk[0], Mk[1]); g3.y = cvtpk(Mk[2], Mk[3]); g3.z = cvtpk(-Mb[0], -Mb[1]); g3.w = cvtpk(-Mb[2], -Mb[3]); ((u32x4*)(rec + CK_G3))[lane] = g3;
        *(LAS f32x4*)(Wf + lr * 16 + 4 * Q) = Nb;
    }
    asm volatile("s_waitcnt lgkmcnt(0)" ::: "memory");
    {
        float Tr[16];
#pragma unroll
        for (int tt = 0; tt < 16; ++tt) {
            const f32x4 zz = (f32x4){0.f, 0.f, 0.f, 0.f};
            const f32x4 n0 = (tt > 0) ? *(const LAS f32x4*)(Wf + tt * 16) : zz, n1 = (tt > 4) ? *(const LAS f32x4*)(Wf + tt * 16 + 4) : zz, n2 = (tt > 8) ? *(const LAS f32x4*)(Wf + tt * 16 + 8) : zz, n3 = (tt > 12) ? *(const LAS f32x4*)(Wf + tt * 16 + 12) : zz;
            const float nt[16] = {n0[0], n0[1], n0[2], n0[3], n1[0], n1[1], n1[2], n1[3], n2[0], n2[1], n2[2], n2[3], n3[0], n3[1], n3[2], n3[3]};
            float sacc = (tt == lr) ? 1.0f : 0.0f;
#pragma unroll
            for (int m = 0; m < tt; ++m) sacc -= Tr[m] * nt[m];
            Tr[tt] = sacc;
        }
        if (Q == 0) {
#pragma unroll
            for (int q = 0; q < 4; ++q) *(LAS f32x4*)(Wf + 256 + lr * 16 + 4 * q) = (f32x4){Tr[4 * q], Tr[4 * q + 1], Tr[4 * q + 2], Tr[4 * q + 3]}; }
    }
    asm volatile("s_waitcnt lgkmcnt(0)" ::: "memory");
    { u32x2 g2; g2.x = cvtpk(Wf[256 + (4 * Q) * 16 + lr], Wf[256 + (4 * Q + 1) * 16 + lr]); g2.y = cvtpk(Wf[256 + (4 * Q + 2) * 16 + lr], Wf[256 + (4 * Q + 3) * 16 + lr]);
      ((u32x2*)(rec + CK_G2))[lane] = g2; }
    asm volatile("s_waitcnt lgkmcnt(0)" ::: "memory");
}
struct ChunkRec { u32x4 at0, at1, rt0, rt1, kb0, kb1, kb2, kb3, g3; u32x2 vf, g1, g2; f32x4 w0, w1, w2, w3; };
constexpr int RING_SLOTS = 8, RING_DIST = 6;
__device__ __forceinline__ void rwkv_seq_window(LAS unsigned char* lds, int hh, int win, const unsigned char* CKBw, float* SBUF, bf16_t* Y, int tid) {
    const int wave = __builtin_amdgcn_readfirstlane(tid >> 6), lane = tid & 63;
    const unsigned char* rec0 = CKBw + (size_t)hh * WINCH * CK_BYTES;
    if (wave >= 4) {
        const int lw = wave - 4;
#define RING_ISSUE(chunk_) do { const unsigned char* g_ = rec0 + (size_t)(chunk_) * CK_BYTES + lane * 16; LAS unsigned char* d_ = lds + ((chunk_) & (RING_SLOTS - 1)) * CK_BYTES; \
            __builtin_amdgcn_global_load_lds((const unsigned*)(g_ + lw * 1024), (LAS unsigned*)(d_ + lw * 1024), 16, 0, 0); \
            __builtin_amdgcn_global_load_lds((const unsigned*)(g_ + (lw + 4) * 1024), (LAS unsigned*)(d_ + (lw + 4) * 1024), 16, 0, 0); \
            __builtin_amdgcn_global_load_lds((const unsigned*)(g_ + (lw + 8) * 1024), (LAS unsigned*)(d_ + (lw + 8) * 1024), 16, 0, 0); \
            if (lw == 0 && lane < 16) __builtin_amdgcn_global_load_lds((const unsigned*)(g_ + 12288), (LAS unsigned*)(d_ + 12288), 16, 0, 0); } while (0)
#pragma unroll
        for (int c = 0; c < RING_DIST; ++c) RING_ISSUE(c);
        asm volatile("s_waitcnt vmcnt(12)" ::: "memory");
        __builtin_amdgcn_s_barrier();
        for (int c = 0; c < WINCH; ++c) {
            if (c + RING_DIST < WINCH) { RING_ISSUE(c + RING_DIST); asm volatile("s_waitcnt vmcnt(12)" ::: "memory"); }
            else asm volatile("s_waitcnt vmcnt(0)" ::: "memory");
            __builtin_amdgcn_s_barrier();
        }
#undef RING_ISSUE
        return;
    }
    const int vt = wave, lr = lane & 15, Q = lane >> 4, b = hh / 12, h = hh % 12;
    f32x4 S0, S1, S2, S3;
    f32x4* sb = (f32x4*)SBUF + ((size_t)(hh * 4 + vt) * 4) * 64 + lane;
    if (win == 0) { S0 = S1 = S2 = S3 = (f32x4){0.f, 0.f, 0.f, 0.f}; } else { S0 = sb[0]; S1 = sb[64]; S2 = sb[128]; S3 = sb[192]; }
#define CK_LOAD(R, chunk_) do { const LAS unsigned char* q_ = lds + ((chunk_) & (RING_SLOTS - 1)) * CK_BYTES; R.at0 = ((const LAS u32x4*)(q_ + CK_AT))[lane]; R.at1 = ((const LAS u32x4*)(q_ + CK_AT))[64 + lane]; R.rt0 = ((const LAS u32x4*)(q_ + CK_RT))[lane]; R.rt1 = ((const LAS u32x4*)(q_ + CK_RT))[64 + lane]; \
        R.kb0 = ((const LAS u32x4*)(q_ + CK_KB))[lane]; R.kb1 = ((const LAS u32x4*)(q_ + CK_KB))[64 + lane]; R.kb2 = ((const LAS u32x4*)(q_ + CK_KB))[128 + lane]; R.kb3 = ((const LAS u32x4*)(q_ + CK_KB))[192 + lane]; \
        R.g3 = ((const LAS u32x4*)(q_ + CK_G3))[lane]; R.vf = ((const LAS u32x2*)(q_ + CK_VF))[vt * 64 + lane]; R.g1 = ((const LAS u32x2*)(q_ + CK_G1))[lane]; R.g2 = ((const LAS u32x2*)(q_ + CK_G2))[lane]; \
        const LAS float* w_ = (const LAS float*)(q_ + CK_W) + 4 * Q; R.w0 = *(const LAS f32x4*)(w_); R.w1 = *(const LAS f32x4*)(w_ + 16); R.w2 = *(const LAS f32x4*)(w_ + 32); R.w3 = *(const LAS f32x4*)(w_ + 48); } while (0)
#define BF8(x) __builtin_bit_cast(bf16x8, (x))
#define CK_STEP(R, cw_) do { const f32x4 z4 = (f32x4){0.f, 0.f, 0.f, 0.f}; \
        const u32x4 bS0 = (u32x4){cvtpk(S0[0], S0[1]), cvtpk(S0[2], S0[3]), cvtpk(S1[0], S1[1]), cvtpk(S1[2], S1[3])}, bS1 = (u32x4){cvtpk(S2[0], S2[1]), cvtpk(S2[2], S2[3]), cvtpk(S3[0], S3[1]), cvtpk(S3[2], S3[3])}; \
        f32x4 Z = __builtin_amdgcn_mfma_f32_16x16x32_bf16(BF8(((u32x4){R.g1.x, R.g1.y, 0u, 0u})), BF8(((u32x4){R.vf.x, R.vf.y, 0u, 0u})), z4, 0, 0, 0); \
        Z = __builtin_amdgcn_mfma_f32_16x16x32_bf16(BF8(R.at0), BF8(bS0), Z, 0, 0, 0); Z = __builtin_amdgcn_mfma_f32_16x16x32_bf16(BF8(R.at1), BF8(bS1), Z, 0, 0, 0); \
        f32x4 Yt = __builtin_amdgcn_mfma_f32_16x16x32_bf16(BF8(R.rt0), BF8(bS0), z4, 0, 0, 0); Yt = __builtin_amdgcn_mfma_f32_16x16x32_bf16(BF8(R.rt1), BF8(bS1), Yt, 0, 0, 0); \
        const f32x4 Dm = __builtin_amdgcn_mfma_f32_16x16x32_bf16(BF8(((u32x4){R.g2.x, R.g2.y, 0u, 0u})), BF8(((u32x4){cvtpk(Z[0], Z[1]), cvtpk(Z[2], Z[3]), 0u, 0u})), z4, 0, 0, 0); \
        const u32x4 bVD = (u32x4){R.vf.x, R.vf.y, cvtpk(Dm[0], Dm[1]), cvtpk(Dm[2], Dm[3])}; \
        Yt = __builtin_amdgcn_mfma_f32_16x16x32_bf16(BF8(R.g3), BF8(bVD), Yt, 0, 0, 0); \
        S0 = __builtin_amdgcn_mfma_f32_16x16x32_bf16(BF8(R.kb0), BF8(bVD), S0, 0, 0, 0) * R.w0; S1 = __builtin_amdgcn_mfma_f32_16x16x32_bf16(BF8(R.kb1), BF8(bVD), S1, 0, 0, 0) * R.w1; \
        S2 = __builtin_amdgcn_mfma_f32_16x16x32_bf16(BF8(R.kb2), BF8(bVD), S2, 0, 0, 0) * R.w2; S3 = __builtin_amdgcn_mfma_f32_16x16x32_bf16(BF8(R.kb3), BF8(bVD), S3, 0, 0, 0) * R.w3; \
        bf16_t* yp_ = Y + ((size_t)b * T + (size_t)(win * WINCH + (cw_)) * CH + 4 * Q) * D + h * 64 + 16 * vt + lr; \
        yp_[0] = f2bf(Yt[0]); yp_[D] = f2bf(Yt[1]); yp_[2 * D] = f2bf(Yt[2]); yp_[3 * D] = f2bf(Yt[3]); } while (0)
    ChunkRec RA, RB;
    __builtin_amdgcn_s_barrier();
    CK_LOAD(RA, 0);
    for (int cw = 0; cw < WINCH; cw += 2) {
        CK_LOAD(RB, cw + 1);
        CK_STEP(RA, cw);
        asm volatile("s_waitcnt lgkmcnt(0)" ::: "memory");
        __builtin_amdgcn_s_barrier();
        if (cw + 2 < WINCH) CK_LOAD(RA, cw + 2);
        CK_STEP(RB, cw + 1);
        asm volatile("s_waitcnt lgkmcnt(0)" ::: "memory");
        __builtin_amdgcn_s_barrier();
    }
#undef CK_LOAD
#undef CK_STEP
#undef BF8
    sb[0] = S0; sb[64] = S1; sb[128] = S2; sb[192] = S3;
}

#define XB_TMO      128
#define XB_XCNT(j)  (256  + 64 * (j))
#define XB_XSUB(j)  (1280 + 64 * (j))
#define XB_XGEN(j)  (2304 + 64 * (j))
#define XB_TOP      3328
#define XB_TOPGEN   3392
#define XCD_BAR_WORDS 3456
#define XB_SPIN_CAP (1u << 22)
__device__ __forceinline__ unsigned xb_ld(unsigned* p)              { return __hip_atomic_load(p, __ATOMIC_RELAXED, __HIP_MEMORY_SCOPE_AGENT); }
__device__ __forceinline__ unsigned xb_add(unsigned* p, unsigned v) { return __hip_atomic_fetch_add(p, v, __ATOMIC_RELAXED, __HIP_MEMORY_SCOPE_AGENT); }
__device__ __forceinline__ unsigned xb_xcc_id() { return (unsigned)__builtin_amdgcn_s_getreg((3 << 11) | 20) & 0xFu; }
#define XB_SPIN(cond, bar) do { unsigned _sp = 0; while (cond) { __builtin_amdgcn_s_sleep(1); \
    if ((++_sp & 255u) == 0u) { if (xb_ld(&(bar)[XB_TMO])) break; if (_sp > XB_SPIN_CAP) { atomicAdd(&(bar)[XB_TMO], 1u); break; } } } } while (0)
struct XcdBarrier { unsigned* bar; unsigned x; volatile LAS unsigned* st; };
__device__ __forceinline__ XcdBarrier xcd_barrier_post(unsigned* bar, volatile LAS unsigned* st) {
    XcdBarrier b; b.bar = bar; b.x = xb_xcc_id(); b.st = st;
    if (threadIdx.x == 0) (void)xb_add(&bar[XB_XCNT(b.x)], 1u);
    return b;
}
__device__ __forceinline__ void xcd_barrier_complete(unsigned* bar, unsigned x, unsigned& nloc, unsigned& nx) {
    const unsigned G = gridDim.x * gridDim.y * gridDim.z;
    unsigned sum, cnt, mine, sp = 0u;
    for (;;) {
        sum = 0u; cnt = 0u; mine = 0u;
#pragma unroll
        for (unsigned j = 0; j < 16; ++j) { const unsigned c = xb_ld(&bar[XB_XCNT(j)]); sum += c; cnt += (c > 0u) ? 1u : 0u; mine = (j == x) ? c : mine; }
        if (sum == G) break;
        __builtin_amdgcn_s_sleep(1);
        if ((++sp & 255u) == 0u) { if (xb_ld(&bar[XB_TMO])) break; if (sp > XB_SPIN_CAP) { atomicAdd(&bar[XB_TMO], 1u); break; } }
    }
    nloc = mine > 0u ? mine : 1u; nx = cnt > 0u ? cnt : 1u;
}
__device__ __forceinline__ void xcd_barrier(const XcdBarrier& b) {
    asm volatile("s_waitcnt vmcnt(0)" ::: "memory");
    __syncthreads();
    if (threadIdx.x == 0) {
        unsigned* bar = b.bar;
        __builtin_amdgcn_s_waitcnt(0);
        unsigned nloc = b.st[0], nx = b.st[1];
        if (nloc == 0u) { xcd_barrier_complete(bar, b.x, nloc, nx); b.st[0] = nloc; b.st[1] = nx; }
        const unsigned old = xb_add(&bar[XB_XSUB(b.x)], 1u);
        const unsigned gen = old / nloc;
        if (old + 1u == (gen + 1u) * nloc) {
            __builtin_amdgcn_fence(__ATOMIC_RELEASE, "agent");
            asm volatile("s_waitcnt vmcnt(0)" ::: "memory");
            const unsigned og = xb_add(&bar[XB_TOP], 1u);
            const unsigned tg = og / nx;
            if (og + 1u == (tg + 1u) * nx) xb_add(&bar[XB_TOPGEN], 1u);
            else XB_SPIN(xb_ld(&bar[XB_TOPGEN]) == tg, bar);
            __builtin_amdgcn_fence(__ATOMIC_ACQUIRE, "agent");
            xb_add(&bar[XB_XGEN(b.x)], 1u);
            asm volatile("s_waitcnt vmcnt(0)" ::: "memory");
        } else {
            XB_SPIN(xb_ld(&bar[XB_XGEN(b.x)]) == gen, bar);
            __builtin_amdgcn_fence(__ATOMIC_ACQUIRE, "agent");
            asm volatile("s_waitcnt vmcnt(0)" ::: "memory");
        }
    }
    __syncthreads();
}

__device__ __forceinline__ void fixup_panel(int tid, int pm, const float* cw, const float* cb, const float* HU, bf16_t* Z) {
    for (int i = tid; i < 4 * (FF / 4); i += 512) {
        const int c = (i % (FF / 4)) * 4, gs = 4 * pm + i / (FF / 4), s = gs & 1, grp = gs >> 1; const bool first = (grp & 31) == 0;
        const float* h0 = HU + (size_t)grp * 4 * FF2; const float* hp = HU + (size_t)(grp - 1) * 4 * FF2;
        const f32x4 z4 = (f32x4){0.f, 0.f, 0.f, 0.f};
        float zz[4];
#pragma unroll
        for (int half = 0; half < 2; ++half) {
            const int cc = half * FF + c;
            const f32x4 ut = *(const f32x4*)(h0 + (size_t)s * FF2 + cc);
            const f32x4 u1 = s ? *(const f32x4*)(h0 + cc) : (first ? z4 : *(const f32x4*)(hp + 3 * (size_t)FF2 + cc));
            const f32x4 u2 = s ? (first ? z4 : *(const f32x4*)(hp + 3 * (size_t)FF2 + cc)) : (first ? z4 : *(const f32x4*)(hp + 2 * (size_t)FF2 + cc));
            const f32x4 cv = *(const f32x4*)(cb + cc) + *(const f32x4*)(cw + cc) * u2 + *(const f32x4*)(cw + FF2 + cc) * u1 + *(const f32x4*)(cw + 2 * FF2 + cc) * ut;
#pragma unroll
            for (int j = 0; j < 4; ++j) zz[j] = half ? zz[j] * cv[j] : cv[j] * sigmoidf_(cv[j]);
        }
        u32x2 w; w.x = cvtpk(zz[0], zz[1]); w.y = cvtpk(zz[2], zz[3]);
        *(u32x2*)(Z + (size_t)(grp * 128 + s) * FF + c) = w;
    }
}

constexpr int NPH = 20;
constexpr int LDS_BYTES = 147456;
__global__ void __launch_bounds__(512, 2) mega(Params p) {
    extern __shared__ __attribute__((aligned(16))) unsigned char lds_raw[];
    LAS unsigned char* lds = (LAS unsigned char*)lds_raw;
    cg::grid_group grid = cg::this_grid();
    const int G = gridDim.x, bx = blockIdx.x;
    const int ngw = G * 8;
#define PH_BEGIN int tid = threadIdx.x; asm volatile("" : "+v"(tid)); const int lane = tid & 63, wave = __builtin_amdgcn_readfirstlane(tid >> 6), gw = bx * 8 + wave; (void)lane; (void)gw;
    unsigned char* ws = p.ws;
    unsigned* ctl = (unsigned*)(ws + WS_CTL);
    float* out = p.out;
    bf16_t* XN = (bf16_t*)(ws + WS_A); bf16_t* Y = (bf16_t*)(ws + WS_Y); bf16_t* P = (bf16_t*)(ws + WS_P); float* X2 = (float*)(ws + WS_X2);
    unsigned short* WL = (unsigned short*)(ws + WS_WL); bf16_t* AB = (bf16_t*)(ws + WS_KMOD); bf16_t* Gt = (bf16_t*)(ws + WS_G);
    bf16_t* KK = (bf16_t*)((unsigned char*)out + DO_KK); bf16_t* ACT = (bf16_t*)((unsigned char*)out + DO_ACT);
    float* ROPE = (float*)(ws + WS_ROPE); bf16_t* MEMN = (bf16_t*)(ws + WS_MEMN); bf16_t* MEMKV = (bf16_t*)(ws + WS_MEMKV); float* LSE = (float*)(ws + WS_LSE); float* SSQ = (float*)(ws + WS_SSQ); float* RS = (float*)(ws + WS_RS);
    bf16_t* XN1 = (bf16_t*)(ws + WS_XN1); bf16_t* Y1 = (bf16_t*)(ws + WS_Y1); bf16_t* OG = (bf16_t*)(ws + WS_OG);
#ifndef PHMASK
#define PHMASK 0xfffff
#endif
#define IN(k) ((((PHMASK) >> (k)) & 1) && p.ph_lo <= (k) && (k) < p.ph_hi)
#define SYNC(k) do { if (IN(k) && IN((k) + 1)) xcd_barrier(xbar); } while (0)
    if (p.ph_lo > 1000) grid.sync();
    { volatile LAS unsigned* st = (volatile LAS unsigned*)(lds + 140032); if (threadIdx.x == 0) { st[0] = 0u; st[1] = 0u; } __syncthreads(); }
    const XcdBarrier xbar = xcd_barrier_post(ctl + 4096, (volatile LAS unsigned*)(lds + 140032));

    if (IN(0)) { PH_BEGIN
        LAS float* scr = (LAS float*)(lds + wave * 16384);
        const float* an = p.in[I_ATTN_NORM]; const float* fn = p.in[I_FFN_NORM]; const float* mn = p.in[I_MEM_NORM];
        constexpr int C0 = 16 * 88, C1 = 16 * 32, C2 = 16 * 48, C3 = 16 * 32, C4 = 8 * 32, C5 = 16 * 16, C6 = 16 * 176, C7 = 44 * 32, C8 = 24, C9 = 48;
        constexpr int NITEMS = C0 + C1 + C2 + C3 + C4 + 2 * C5 + 2 * C6 + 2 * C7 + 2 * C8 + C9;
        for (int it = gw; it < NITEMS; it += ngw) {
            int r = it;
            if (r < C0) { const int nb = AIN / 32; tr_item(p.in[I_A_W_IN], AIN, an, (bf16_t*)(ws + WS_WAIN), D, 0, (r % nb) * 32, (r / nb) * 64, (r % nb) * 32, scr, lane); continue; } r -= C0;
            if (r < C1) { const int nb = 32; tr_item(p.in[I_A_W_OUT], D, nullptr, (bf16_t*)(ws + WS_WAOUT), D, 0, (r % nb) * 32, (r / nb) * 64, (r % nb) * 32, scr, lane); continue; } r -= C1;
            if (r < C2) { const int nb = 48; tr_item(p.in[I_KV_W], 1536, p.in[I_KV_NORM], (bf16_t*)(ws + WS_WIN1), D, 0, (r % nb) * 32, (r / nb) * 64, (r % nb) * 32, scr, lane); continue; } r -= C2;
            if (r < C3) { const int nb = 32; tr_item(p.in[I_B_W_IN], D, an + D, (bf16_t*)(ws + WS_WIN1), D, 0, 1536 + (r % nb) * 32, (r / nb) * 64, (r % nb) * 32, scr, lane); continue; } r -= C3;
            if (r < C4) { const int nb = 32; tr_item(p.in[I_B_W_OUT], D, nullptr, (bf16_t*)(ws + WS_WBOUT), 512, 0, (r % nb) * 32, (r / nb) * 64, (r % nb) * 32, scr, lane); continue; } r -= C4;
            if (r < 2 * C5) { const int l = r / C5; r -= l * C5; const int nb = 16; tr_item(p.in[I_MEM_W_KV] + (size_t)l * D * 512, 512, mn + l * D, (bf16_t*)(ws + WS_WMEM), D, 0, l * 512 + (r % nb) * 32, (r / nb) * 64, (r % nb) * 32, scr, lane); continue; } r -= 2 * C5;
            if (r < 2 * C6) { const int l = r / C6; r -= l * C6; const int nb = 176; const int n0 = (r % nb) * 32; const int drow = (n0 < FF) ? 256 * (n0 / 128) + (n0 % 128) : 256 * ((n0 - FF) / 128) + 128 + ((n0 - FF) % 128);
                tr_item(p.in[I_FFN_W_UP] + (size_t)l * D * FF2, FF2, fn + l * D, (bf16_t*)(ws + (l ? WS_WUP1 : WS_WUP0)), D, 0, drow, (r / nb) * 64, n0, scr, lane); continue; } r -= 2 * C6;
            if (r < 2 * C7) { const int l = r / C7; r -= l * C7; const int nb = 32; tr_item(p.in[I_FFN_W_DOWN] + (size_t)l * FF * D, D, nullptr, (bf16_t*)(ws + (l ? WS_WDN1 : WS_WDN0)), FF, 0, (r % nb) * 32, (r / nb) * 64, (r % nb) * 32, scr, lane); continue; } r -= 2 * C7;
            if (r < C8) { tr_item(p.in[I_A_W2], RW, nullptr, (bf16_t*)(ws + WS_WLORA), 256, 0, r * 32, 0, r * 32, scr, lane); continue; } r -= C8;
            if (r < C8) { tr_item(p.in[I_A_A2], RW, nullptr, (bf16_t*)(ws + WS_WLORA), 256, 64, 768 + r * 32, 0, r * 32, scr, lane); continue; } r -= C8;
            { const int nb = 24; tr_item(p.in[I_A_G2], RW, nullptr, (bf16_t*)(ws + WS_WLORA), 256, 128, 1536 + (r % nb) * 32, (r / nb) * 64, (r % nb) * 32, scr, lane); }
        }
        { bf16_t* WLr = (bf16_t*)(ws + WS_WLORA);
          for (int i = bx * 512 + tid; i < 2304 * 32; i += G * 512) { const int row = i >> 5, c8 = (i & 31) * 8; const int grp = row / 768;
              const bool nz = (grp == 0) ? (c8 < 64) : (grp == 1) ? (c8 >= 64 && c8 < 128) : (c8 >= 128);
              if (!nz) *(u32x4*)(WLr + (size_t)row * 256 + c8) = (u32x4){0u, 0u, 0u, 0u}; } }
        for (int i = bx * 512 + tid; i < T * 32; i += G * 512) { const int pos = i >> 5, f = i & 31; const float inv = powf(10000.0f, -(float)(2 * f) / 64.0f); const float ang = (float)pos * inv;
            ROPE[i] = cosf(ang); ROPE[T * 32 + i] = sinf(ang); }
        rms_pass(p.in[I_X], XN, M, gw, ngw, lane, RS);
        rms_pass(p.in[I_MEM], MEMN, NB * NMEM, gw, ngw, lane);
    }
    SYNC(0);
    if (IN(1)) {
        { pg8::Gemm g{XN, (const bf16_t*)(ws + WS_WAIN), M, AIN, D}; pg8::StaticOrder S; S.init(M, AIN, G, bx); EpiBf16 E{P, AIN, RS}; pg8::gemm_phase(lds, g, S, E); }
        { pg8::Gemm g{MEMN, (const bf16_t*)(ws + WS_WMEM), 2048, D, D}; pg8::StaticOrder S; S.init(2048, D, G, (bx + 128) % G); EpiBf16 E{MEMKV, D, nullptr}; pg8::gemm_phase(lds, g, S, E); }
    }
    SYNC(1);
    if (IN(2)) { PH_BEGIN
        const float* mu = p.in[I_A_MU];
        for (int i0 = bx * 512 + tid; i0 < M * 32; i0 += G * 512 * 4) {
            u32x4 wc_[4], wp_[4];
#pragma unroll
            for (int u = 0; u < 4; ++u) { const int i = i0 + u * G * 512; const int tok = i >> 5, lc = i & 31; const bool first = (tok & (T - 1)) == 0; const int col = 2304 + lc * 8;
                wc_[u] = *(const u32x4*)(P + (size_t)tok * AIN + col); wp_[u] = *(const u32x4*)(P + (size_t)(first ? tok : tok - 1) * AIN + col); }
#pragma unroll
            for (int u = 0; u < 4; ++u) { const int i = i0 + u * G * 512; const int tok = i >> 5, lc = i & 31; const bool first = (tok & (T - 1)) == 0; const int col = 2304 + lc * 8, q = lc >> 3;
                float pc[8], pp[8], xs[8];
                unpack8(wc_[u], pc); unpack8(wp_[u], pp);
                const f32x4 m0 = *(const f32x4*)(mu + col), m1 = *(const f32x4*)(mu + col + 4);
#pragma unroll
                for (int j = 0; j < 8; ++j) { const float pv = first ? 0.f : pp[j]; const float x = pc[j] + (pv - pc[j]) * (j < 4 ? m0[j] : m1[j - 4]); xs[j] = (q == 0) ? tanhf(x) : (q == 1) ? x : sigmoidf_(x); }
                *(u32x4*)(ACT + (size_t)tok * 256 + lc * 8) = pack8(xs); }
        }
    }
    SYNC(2);
    if (IN(3)) {
        pg8::Gemm g{ACT, (const bf16_t*)(ws + WS_WLORA), M, 2304, 256}; pg8::StaticOrder S; S.init(M, 2304, G, bx);
        EpiLora E{p.in[I_A_W0], p.in[I_A_A0], WL, AB, Gt};
        pg8::gemm_phase(lds, g, S, E);
    }
    SYNC(3);
    if (IN(4)) { PH_BEGIN
        unsigned char* CKB = (unsigned char*)out + 48 * MiB; float* SBUF = (float*)(ws + WS_SSQ);
        constexpr size_t CKWIN = (size_t)96 * WINCH * CK_BYTES;
        constexpr int NPT = 96 * (WINCH / 8);
#define PREP_TASK(pw_, u_) do { const int u__ = (u_); const int hh__ = u__ / (WINCH / 8), cw__ = (u__ % (WINCH / 8)) * 8 + wave; \
            rwkv_prep2(lds + wave * PREP_LDS, hh__, (pw_) * WINCH + cw__, CKB + (size_t)((pw_) & 1) * CKWIN + (size_t)(hh__ * WINCH + cw__) * CK_BYTES, P, WL, AB, p.in[I_A_K_K], p.in[I_A_MU], p.in[I_A_K_A], p.in[I_A_R_K], LSE, lane); } while (0)
#define XU(x_, t_) ((((x_) + 8 * ((t_) >> 2)) * 4) + ((t_) & 3))
#define TASK_OF(k_, pw_, u_, ok_) do { const int k__ = (k_); if (k__ < 2) { pw_ = 0; const int t__ = (bx >> 3) + 32 * k__; ok_ = t__ < 48; u_ = XU(bx & 7, ok_ ? t__ : 0); } \
            else { pw_ = 1 + ((k__ - 2) >> 1); u_ = XU(bx & 7, ((bx - 96) >> 3) * 2 + ((k__ - 2) & 1)); ok_ = pw_ < NWIN; } } while (0)
#define TASK_CHUNK(pw_, u_, hh_, cc_, rec_) do { hh_ = (u_) / (WINCH / 8); const int cw__ = ((u_) % (WINCH / 8)) * 8 + wave; cc_ = (pw_) * WINCH + cw__; rec_ = CKB + (size_t)((pw_) & 1) * CKWIN + (size_t)(hh_ * WINCH + cw__) * CK_BYTES; } while (0)
        if (bx >= 96) {
            int pw, u, hh, cc; bool ok; unsigned char* rec;
            for (int k = 0; k < 2 * NWIN; ++k) {
                TASK_OF(k, pw, u, ok); TASK_CHUNK(pw, u, hh, cc, rec);
                if (ok) rwkv_prep2(lds + wave * PREP_LDS, hh, cc, rec, P, WL, AB, p.in[I_A_K_K], p.in[I_A_MU], p.in[I_A_K_A], p.in[I_A_R_K], LSE, lane);
                if (k & 1) xcd_barrier(xbar);
            }
            xcd_barrier(xbar);
        } else {
            for (int t = (bx >> 3); t < 48; t += 32) PREP_TASK(0, XU(bx & 7, t));
            xcd_barrier(xbar);
            for (int win = 0; win < NWIN; ++win) {
                rwkv_seq_window(lds, bx, win, CKB + (size_t)(win & 1) * CKWIN, SBUF, Y, tid); asm volatile("s_waitcnt lgkmcnt(0)" ::: "memory"); __builtin_amdgcn_s_barrier(); asm volatile("" ::: "memory");
                if (win + 1 < NWIN && bx < 64) PREP_TASK(win + 1, XU(bx & 7, 40 + (bx >> 3)));
                xcd_barrier(xbar);
            }
        }
#undef TASK_OF
#undef XU
#undef TASK_CHUNK
#undef PREP_TASK
        {
#define MEM0_DESC(v_) AttnDesc{P + (size_t)((v_) >> 5) * T * AIN + SHIFTW + (((v_) >> 3) & 3) * 64, MEMKV + (size_t)((v_) >> 5) * NMEM * D + (((v_) >> 3) & 3) * 64, MEMKV + (size_t)((v_) >> 5) * NMEM * D + 256 + (((v_) >> 3) & 3) * 64, \
                Y + (size_t)((v_) >> 5) * T * D + RW + (((v_) >> 3) & 3) * 64, nullptr, p.in[I_MEM_Q_NORM], p.in[I_MEM_K_NORM], AIN, D, D, 0, 1, ((v_) & 7) * 4}
            AttnDesc cur = MEM0_DESC(bx); AttnRaw R; attn_issue<false>(cur, R, tid);
            for (int v = bx; v < 256; v += G) { const bool has = v + G < 256; const AttnDesc nd = MEM0_DESC(has ? v + G : v); attn_body<false>(lds, cur, R, nullptr, has, nd); cur = nd; }
#undef MEM0_DESC
        }
    }
    if (IN(5)) { PH_BEGIN
        const float* mu = p.in[I_A_MU]; const float* lw = p.in[I_A_LNX_W]; const float* lb = p.in[I_A_LNX_B];
        for (int i0 = bx * 512 + tid; i0 < M * 96; i0 += G * 512 * 4) {
            u32x4 wy[4], wg[4], wc_[4], wp_[4]; float rk[4];
#pragma unroll
            for (int u = 0; u < 4; ++u) { const int i = i0 + u * G * 512; const int tok = i / 96, c8 = (i % 96) * 8; const bool first = (tok & (T - 1)) == 0;
                wy[u] = *(const u32x4*)(Y + (size_t)tok * D + c8); wg[u] = __builtin_nontemporal_load((const u32x4*)(Gt + (size_t)tok * RW + c8));
                wc_[u] = *(const u32x4*)(P + (size_t)tok * AIN + 1536 + c8); wp_[u] = *(const u32x4*)(P + (size_t)(first ? tok : tok - 1) * AIN + 1536 + c8);
                rk[u] = LSE[(size_t)tok * 12 + (c8 >> 6)]; }
#pragma unroll
            for (int u = 0; u < 4; ++u) { const int i = i0 + u * G * 512; const int tok = i / 96, c8 = (i % 96) * 8; const bool first = (tok & (T - 1)) == 0;
                float y[8], g[8], pc[8], pp[8];
                unpack8(wy[u], y); unpack8(wg[u], g); unpack8(wc_[u], pc); unpack8(wp_[u], pp);
                float s1 = 0.f;
#pragma unroll
                for (int j = 0; j < 8; ++j) s1 += y[j];
                const float mean = red8(s1) * (1.f / 64.f);
                float s2 = 0.f;
#pragma unroll
                for (int j = 0; j < 8; ++j) { y[j] -= mean; s2 += y[j] * y[j]; }
                const float rstd = rsqrtf(red8(s2) * (1.f / 64.f) + LNX_EPS);
                const f32x4 mA = *(const f32x4*)(mu + 1536 + c8), mB = *(const f32x4*)(mu + 1536 + c8 + 4), lwA = *(const f32x4*)(lw + c8), lwB = *(const f32x4*)(lw + c8 + 4), lbA = *(const f32x4*)(lb + c8), lbB = *(const f32x4*)(lb + c8 + 4);
                float o[8];
#pragma unroll
                for (int j = 0; j < 8; ++j) { const float pv = first ? 0.f : pp[j]; const float vv = pc[j] + (pv - pc[j]) * (j < 4 ? mA[j] : mB[j - 4]);
                    o[j] = (y[j] * rstd * (j < 4 ? lwA[j] : lwB[j - 4]) + (j < 4 ? lbA[j] : lbB[j - 4]) + rk[u] * vv) * g[j]; }
                *(u32x4*)(Y + (size_t)tok * D + c8) = pack8(o); }
        }
    }
    SYNC(5);
    if (IN(6)) { pg8::Gemm g{Y, (const bf16_t*)(ws + WS_WAOUT), M, D, D}; pg8::StaticOrder S; S.init(M, D, G, bx); EpiResid E{nullptr, XN, nullptr, XN, SSQ}; pg8::gemm_phase(lds, g, S, E); }
    SYNC(6);
#define FOR_PANELS(Nv_, BODY_) do { pg8::StaticOrder S_; S_.init(M, (Nv_), G, bx); pg8::Unit u_; int last_ = -1; for (int i_ = 0; S_.next(i_, u_); ++i_) if (u_.pm != last_) { last_ = u_.pm; const int pm_ = u_.pm; BODY_ } } while (0)
#define RS_PANEL() { if (tid < 256) { const int r_ = pm_ * 256 + tid; const f32x4* q_ = (const f32x4*)(SSQ + (size_t)r_ * 16); const f32x4 a_ = (q_[0] + q_[1]) + (q_[2] + q_[3]); \
        RS[r_] = rsqrtf(((a_[0] + a_[1]) + (a_[2] + a_[3])) * (1.f / D) + RMS_EPS); } }
    if (IN(8)) { { PH_BEGIN FOR_PANELS(FF2, RS_PANEL()); __syncthreads(); }
        pg8::Gemm g{XN, (const bf16_t*)(ws + WS_WUP0), M, FF2, D}; pg8::StaticOrder S; S.init(M, FF2, G, bx); EpiFFN E{p.in[I_FFN_CONV_W], p.in[I_FFN_CONV_B], P, (float*)(ws + WS_HU0), RS}; pg8::gemm_phase(lds, g, S, E); }
    SYNC(8);
    if (IN(10)) { { PH_BEGIN FOR_PANELS(D, { fixup_panel(tid, pm_, p.in[I_FFN_CONV_W], p.in[I_FFN_CONV_B], (const float*)(ws + WS_HU0), P); }); __syncthreads(); }
        pg8::Gemm g{P, (const bf16_t*)(ws + WS_WDN0), M, D, FF}; pg8::StaticOrder S; S.init(M, D, G, bx); EpiResid E{nullptr, XN, nullptr, XN1, SSQ}; pg8::gemm_phase(lds, g, S, E); }
    SYNC(10);
    if (IN(12)) { { PH_BEGIN FOR_PANELS(IN1, RS_PANEL()); __syncthreads(); }
        pg8::Gemm g{XN1, (const bf16_t*)(ws + WS_WIN1), M, IN1, D}; pg8::StaticOrder S; S.init(M, IN1, G, bx); EpiBf16 E{P, IN1, RS}; pg8::gemm_phase(lds, g, S, E); }
    SYNC(12);
    if (IN(13)) { PH_BEGIN
        {
#define DIL_DESC(u_, dsc) do { const int gi = (u_) >> 10, r = (u_) & 1023, b = r >> 7, hs = (r >> 5) & 3, rn = r & 31; \
                const int d = (gi == 0) ? 1 : (gi == 1) ? 4 : 16, nb = 32 / d, head = gi * 4 + hs; const bf16_t* Pb = P + (size_t)b * T * IN1; \
                dsc = AttnDesc{Pb + 1536 + head * 64, Pb + head * 64, Pb + RW + head * 64, OG + ((size_t)gi * M + (size_t)b * T) * 256 + hs * 64, LSE + ((size_t)gi * M + (size_t)b * T) * 4 + hs, \
                               p.in[I_B_Q_NORM], p.in[I_KV_K_NORM], IN1, IN1, 256, rn / nb, d, rn % nb}; } while (0)
            AttnDesc cur, nd; AttnRaw R; DIL_DESC(bx, cur); attn_issue<true>(cur, R, tid);
            for (int u = bx; u < 3072; u += G) { const bool has = u + G < 3072; DIL_DESC(has ? u + G : u, nd); attn_body<true>(lds, cur, R, ROPE, has, nd); cur = nd; }
#undef DIL_DESC
        }
        {
#define MEM1_DESC(v_) AttnDesc{P + (size_t)((v_) >> 5) * T * IN1 + 2304 + (((v_) >> 3) & 3) * 64, MEMKV + (size_t)((v_) >> 5) * NMEM * D + 512 + (((v_) >> 3) & 3) * 64, MEMKV + (size_t)((v_) >> 5) * NMEM * D + 768 + (((v_) >> 3) & 3) * 64, \
                Y1 + (size_t)((v_) >> 5) * T * 512 + 256 + (((v_) >> 3) & 3) * 64, nullptr, p.in[I_MEM_Q_NORM] + 64, p.in[I_MEM_K_NORM] + 64, IN1, D, 512, 0, 1, ((v_) & 7) * 4}
            AttnDesc cur = MEM1_DESC(bx); AttnRaw R; attn_issue<false>(cur, R, tid);
            for (int v = bx; v < 256; v += G) { const bool has = v + G < 256; const AttnDesc nd = MEM1_DESC(has ? v + G : v); attn_body<false>(lds, cur, R, nullptr, has, nd); cur = nd; }
#undef MEM1_DESC
        }
    }
    SYNC(13);
    if (IN(14)) { PH_BEGIN
        for (int i0 = bx * 512 + tid; i0 < M * 32; i0 += G * 512 * 4) {
            u32x4 wa[4], wb[4], wc_[4]; float l0[4], l1[4], l2[4];
#pragma unroll
            for (int u = 0; u < 4; ++u) { const int i = i0 + u * G * 512; const int tok = i >> 5, c8 = (i & 31) * 8, slot = c8 >> 6;
                l0[u] = LSE[((size_t)0 * M + tok) * 4 + slot]; l1[u] = LSE[((size_t)1 * M + tok) * 4 + slot]; l2[u] = LSE[((size_t)2 * M + tok) * 4 + slot];
                wa[u] = __builtin_nontemporal_load((const u32x4*)(OG + ((size_t)0 * M + tok) * 256 + c8)); wb[u] = __builtin_nontemporal_load((const u32x4*)(OG + ((size_t)1 * M + tok) * 256 + c8)); wc_[u] = __builtin_nontemporal_load((const u32x4*)(OG + ((size_t)2 * M + tok) * 256 + c8)); }
#pragma unroll
            for (int u = 0; u < 4; ++u) { const int i = i0 + u * G * 512; const int tok = i >> 5, c8 = (i & 31) * 8;
                const float mxl = fmaxf(l0[u], fmaxf(l1[u], l2[u])); const float e0 = __expf(l0[u] - mxl), e1 = __expf(l1[u] - mxl), e2 = __expf(l2[u] - mxl); const float inv = 1.f / (e0 + e1 + e2);
                float a[8], b[8], c[8], o[8];
                unpack8(wa[u], a); unpack8(wb[u], b); unpack8(wc_[u], c);
#pragma unroll
                for (int j = 0; j < 8; ++j) o[j] = (e0 * a[j] + e1 * b[j] + e2 * c[j]) * inv;
                *(u32x4*)(Y1 + (size_t)tok * 512 + c8) = pack8(o); }
        }
    }
    SYNC(14);
    if (IN(15)) { pg8::Gemm g{Y1, (const bf16_t*)(ws + WS_WBOUT), M, D, 512}; pg8::StaticOrder S; S.init(M, D, G, bx); EpiResid E{nullptr, XN1, nullptr, XN1, SSQ}; pg8::gemm_phase(lds, g, S, E); }
    SYNC(15);
    if (IN(17)) { { PH_BEGIN FOR_PANELS(FF2, RS_PANEL()); __syncthreads(); }
        pg8::Gemm g{XN1, (const bf16_t*)(ws + WS_WUP1), M, FF2, D}; pg8::StaticOrder S; S.init(M, FF2, G, bx); EpiFFN E{p.in[I_FFN_CONV_W] + 3 * FF2, p.in[I_FFN_CONV_B] + FF2, P, (float*)(ws + WS_HU1), RS}; pg8::gemm_phase(lds, g, S, E); }
    SYNC(17);
    if (IN(19)) { { PH_BEGIN FOR_PANELS(D, { fixup_panel(tid, pm_, p.in[I_FFN_CONV_W] + 3 * FF2, p.in[I_FFN_CONV_B] + FF2, (const float*)(ws + WS_HU1), P); }); __syncthreads(); }
        pg8::Gemm g{P, (const bf16_t*)(ws + WS_WDN1), M, D, FF}; pg8::StaticOrder S; S.init(M, D, G, bx); EpiResid E{nullptr, XN1, out, nullptr, nullptr}; pg8::gemm_phase(lds, g, S, E); }
#undef IN
#undef SYNC
}

extern "C" void kernel_launch(void* const* d_in, const int* in_sizes, int n_in, void* d_out, int out_size, void* d_ws, size_t ws_size, hipStream_t stream) {
    static int grid = 0;
    if (grid == 0) {
        if (n_in != 31 || ws_size < WS_END) { fprintf(stderr, "kernel_launch: unexpected n_in %d / ws %zu\n", n_in, ws_size); grid = -1; return; }
        int dev = 0, cus = 0, per_cu = 0;
        hipGetDevice(&dev); hipDeviceGetAttribute(&cus, hipDeviceAttributeMultiprocessorCount, dev);
        if (hipFuncSetAttribute((const void*)mega, hipFuncAttributeMaxDynamicSharedMemorySize, LDS_BYTES) != hipSuccess) { fprintf(stderr, "kernel_launch: hipFuncSetAttribute failed\n"); grid = -1; return; }
        if (hipOccupancyMaxActiveBlocksPerMultiprocessor(&per_cu, (const void*)mega, 512, LDS_BYTES) != hipSuccess || per_cu < 1) { fprintf(stderr, "kernel_launch: occupancy query says %d\n", per_cu); per_cu = 1; }
        (void)hipGetLastError();
        grid = cus * 1;
        if (grid > 256) grid = 256;
    }
    if (grid < 0) return;
    (void)hipMemsetAsync((char*)d_ws + WS_CTL, 0, 65536, stream);
    Params p{};
    for (int i = 0; i < 31; ++i) p.in[i] = (const float*)d_in[i];
    p.out = (float*)d_out; p.ws = (unsigned char*)d_ws; p.ph_lo = 0; p.ph_hi = NPH;
    void* args[] = {&p};
    hipError_t e = hipLaunchCooperativeKernel((const void*)mega, dim3(grid), dim3(512), args, LDS_BYTES, stream);
    if (e != hipSuccess) fprintf(stderr, "cooperative launch failed: %s (grid %d)\n", hipGetErrorString(e), grid);
}
```
